# Optimizing an MI355X kernel written in HIP

```python
import jax, jax.numpy as jnp
from jax import lax
import numpy as np

D_MODEL = 2048
BATCH = 32
SEQ = 256
DEPTH = 1
DEC_BATCH = 8
DEC_SEQ = 2048
PAST_LEN = 512

GRID_W = 64
HEAD_DIM = 128
D_A = D_MODEL // 2
D_B = D_MODEL - D_A
N_HEADS_A = D_A // HEAD_DIM
N_HEADS_B = D_B // HEAD_DIM
N_KV_B = N_HEADS_B // 4
D_KV_B = N_KV_B * HEAD_DIM
NA_ROWS = 8
NA_COLS = 16
Q_BLOCK = 128
ROPE_THETA = 10000.0
EPS = 1e-6
NEG_INF = -1e30
D_IN = 4 * D_A + 2 * D_B + 2 * D_KV_B

kernel_name = "hymba_natten_gqa_prefix_dit_step"


def rms_norm(x, g):
    x32 = x.astype(jnp.float32)
    y = x32 * lax.rsqrt(jnp.mean(x32 * x32, axis=-1, keepdims=True) + EPS)
    return y.astype(x.dtype) * g


def adaln(c, w_ada, b_ada):
    mod = jax.nn.silu(c) @ w_ada + b_ada
    return jnp.split(mod, 3, axis=-1)


def split_heads(z, n_heads):
    b, n, _ = z.shape
    return z.reshape(b, n, n_heads, HEAD_DIM).transpose(0, 2, 1, 3)


def merge_heads(o):
    b, h, n, d = o.shape
    return o.transpose(0, 2, 1, 3).reshape(b, n, h * d)


def project(h, w_in, g_q, g_k):
    z = h @ w_in
    cuts = [D_A, 2 * D_A, 3 * D_A, 4 * D_A, 4 * D_A + D_B,
            4 * D_A + D_B + D_KV_B, 4 * D_A + D_B + 2 * D_KV_B]
    qa, ka, va, ga, qb, kb, vb, gb = jnp.split(z, cuts, axis=-1)
    qa, ka, va = split_heads(qa, N_HEADS_A), split_heads(ka, N_HEADS_A), split_heads(va, N_HEADS_A)
    qb = rms_norm(split_heads(qb, N_HEADS_B), g_q)
    kb = rms_norm(split_heads(kb, N_KV_B), g_k)
    vb = split_heads(vb, N_KV_B)
    return qa, ka, va, ga, qb, kb, vb, gb


def rope_2d(x):
    n = x.shape[2]
    t = jnp.arange(n)
    row = (t // GRID_W).astype(jnp.float32)
    col = (t % GRID_W).astype(jnp.float32)
    half = HEAD_DIM // 2
    inv_freq = ROPE_THETA ** (-jnp.arange(0, half, 2, dtype=jnp.float32) / half)

    def rot(xh, pos):
        ang = pos[:, None] * inv_freq[None, :]
        cos = jnp.cos(ang).astype(x.dtype)
        sin = jnp.sin(ang).astype(x.dtype)
        x1, x2 = jnp.split(xh, 2, axis=-1)
        return jnp.concatenate([x1 * cos - x2 * sin, x2 * cos + x1 * sin], axis=-1)

    return jnp.concatenate([rot(x[..., :half], row), rot(x[..., half:], col)], axis=-1)


def attend_blocks(q, k, v):
    b, hq, n, d = q.shape
    hkv = k.shape[1]
    g = hq // hkv
    nb = n // Q_BLOCK
    scale = d ** -0.5
    qblk = jnp.moveaxis(q.reshape(b, hkv, g, nb, Q_BLOCK, d), 3, 0)

    def blk(qb):
        s = jnp.einsum('bhgqd,bhkd->bhgqk', qb, k).astype(jnp.float32) * scale
        p = jax.nn.softmax(s, axis=-1).astype(v.dtype)
        return jnp.einsum('bhgqk,bhkd->bhgqd', p, v)

    o = lax.map(blk, qblk)
    return jnp.moveaxis(o, 0, 3).reshape(b, hq, n, d)


def neighborhood_attention(q, k, v, k_ctx, v_ctx, rpb):
    b, h, n, d = q.shape
    rows = n // GRID_W
    kh = min(NA_ROWS, rows)
    scale = d ** -0.5
    qg = q.reshape(b, h, rows, GRID_W, d)
    kg = k.reshape(b, h, rows, GRID_W, d)
    vg = v.reshape(b, h, rows, GRID_W, d)
    row_start = jnp.clip(jnp.arange(rows) - kh // 2, 0, rows - kh)
    qc = jnp.arange(GRID_W)
    col_start = jnp.clip(qc - NA_COLS // 2, 0, GRID_W - NA_COLS)
    kc = jnp.arange(GRID_W)
    valid = (kc[None, :] >= col_start[:, None]) & (kc[None, :] < col_start[:, None] + NA_COLS)
    coff = jnp.clip(kc[None, :] - qc[:, None] + NA_COLS - 1, 0, 2 * NA_COLS - 2)

    def row_block(r):
        rs = row_start[r]
        qr = qg[:, :, r]
        kband = lax.dynamic_slice_in_dim(kg, rs, kh, axis=2)
        vband = lax.dynamic_slice_in_dim(vg, rs, kh, axis=2)
        roff = rs + jnp.arange(kh) - r + NA_ROWS - 1
        bias = rpb[:, roff[None, :, None], coff[:, None, :]].astype(jnp.float32)
        s_lat = jnp.einsum('bhqd,bhikd->bhqik', qr, kband).astype(jnp.float32) * scale + bias
        s_lat = jnp.where(valid[:, None, :], s_lat, NEG_INF)
        s_ctx = jnp.einsum('bhqd,bhkd->bhqk', qr, k_ctx).astype(jnp.float32) * scale
        s = jnp.concatenate([s_lat.reshape(b, h, GRID_W, kh * GRID_W), s_ctx], axis=-1)
        p = jax.nn.softmax(s, axis=-1).astype(v.dtype)
        p_lat = p[..., :kh * GRID_W].reshape(b, h, GRID_W, kh, GRID_W)
        p_ctx = p[..., kh * GRID_W:]
        return (jnp.einsum('bhqik,bhikd->bhqd', p_lat, vband)
                + jnp.einsum('bhqk,bhkd->bhqd', p_ctx, v_ctx))

    o = lax.map(row_block, jnp.arange(rows))
    return jnp.moveaxis(o, 0, 2).reshape(b, h, n, d)


def merge_branches(oa, ga, ob, gb, w_out):
    return jnp.concatenate([merge_heads(oa) * jax.nn.silu(ga),
                            merge_heads(ob) * jax.nn.silu(gb)], axis=-1) @ w_out


def context_layer(x, c_ctx, w_ada, b_ada, g_norm, w_in, g_q, g_k, w_out):
    shift, scale, gate = adaln(c_ctx, w_ada, b_ada)
    hmod = rms_norm(x, g_norm) * (1 + scale) + shift
    qa, ka, va, ga, qb, kb, vb, gb = project(hmod, w_in, g_q, g_k)
    oa = attend_blocks(qa, ka, va)
    ob = attend_blocks(qb, kb, vb)
    x = x + gate * merge_branches(oa, ga, ob, gb, w_out)
    return x, ka, va, kb, vb


def latent_layer(x, c, ka_c, va_c, kb_c, vb_c, w_ada, b_ada, g_norm, w_in, rpb, g_q, g_k, w_out):
    shift, scale, gate = adaln(c, w_ada, b_ada)
    shift, scale, gate = shift[:, None, :], scale[:, None, :], gate[:, None, :]
    hmod = rms_norm(x, g_norm) * (1 + scale) + shift
    qa, ka, va, ga, qb, kb, vb, gb = project(hmod, w_in, g_q, g_k)
    qb, kb = rope_2d(qb), rope_2d(kb)
    oa = neighborhood_attention(qa, ka, va, ka_c, va_c, rpb)
    ob = attend_blocks(qb, jnp.concatenate([kb, kb_c], axis=2), jnp.concatenate([vb, vb_c], axis=2))
    return x + gate * merge_branches(oa, ga, ob, gb, w_out)


def setup_inputs(seed: int = 0) -> dict:
    key = jax.random.key(seed)
    ks = jax.random.split(key, 20)
    f32 = jnp.float32
    s_in = D_MODEL ** -0.5
    return {
        "x_prompt": jax.random.normal(ks[0], (BATCH, SEQ, D_MODEL), f32),
        "x_sample": jax.random.normal(ks[1], (DEC_BATCH, DEC_SEQ, D_MODEL), f32),
        "cache_a_k": jax.random.normal(ks[2], (DEC_BATCH, DEPTH, N_HEADS_A, PAST_LEN, HEAD_DIM), f32),
        "cache_a_v": jax.random.normal(ks[3], (DEC_BATCH, DEPTH, N_HEADS_A, PAST_LEN, HEAD_DIM), f32),
        "cache_b_k": jax.random.normal(ks[4], (DEC_BATCH, DEPTH, N_KV_B, PAST_LEN, HEAD_DIM), f32),
        "cache_b_v": jax.random.normal(ks[5], (DEC_BATCH, DEPTH, N_KV_B, PAST_LEN, HEAD_DIM), f32),
        "c": jax.random.normal(ks[6], (DEC_BATCH, D_MODEL), f32),
        "c_ctx": jax.random.normal(ks[7], (D_MODEL,), f32),
        "w_ada": jax.random.normal(ks[8], (DEPTH, D_MODEL, 3 * D_MODEL), f32) * (0.5 * s_in),
        "b_ada": jax.random.normal(ks[9], (DEPTH, 3 * D_MODEL), f32) * 0.01,
        "g_norm": 1.0 + 0.01 * jax.random.normal(ks[10], (DEPTH, D_MODEL), f32),
        "w_in": jax.random.normal(ks[11], (DEPTH, D_MODEL, D_IN), f32) * s_in,
        "rpb": 0.02 * jax.random.normal(ks[12], (DEPTH, N_HEADS_A, 2 * NA_ROWS - 1, 2 * NA_COLS - 1), f32),
        "g_q": 1.0 + 0.01 * jax.random.normal(ks[13], (DEPTH, HEAD_DIM), f32),
        "g_k": 1.0 + 0.01 * jax.random.normal(ks[14], (DEPTH, HEAD_DIM), f32),
        "w_out": jax.random.normal(ks[15], (DEPTH, D_MODEL, D_MODEL), f32) * s_in,
        "g_final": 1.0 + 0.01 * jax.random.normal(ks[16], (D_MODEL,), f32),
    }


def reference(x_prompt, x_sample, cache_a_k, cache_a_v, cache_b_k, cache_b_v, c, c_ctx,
              w_ada, b_ada, g_norm, w_in, rpb, g_q, g_k, w_out, g_final):
    xp, xs = x_prompt, x_sample
    new_ak, new_av, new_bk, new_bv = [], [], [], []
    for l in range(DEPTH):
        xp, ka, va, kb, vb = context_layer(xp, c_ctx, w_ada[l], b_ada[l], g_norm[l],
                                           w_in[l], g_q[l], g_k[l], w_out[l])
        new_ak.append(ka); new_av.append(va); new_bk.append(kb); new_bv.append(vb)
        xs = latent_layer(xs, c, cache_a_k[:, l], cache_a_v[:, l], cache_b_k[:, l], cache_b_v[:, l],
                          w_ada[l], b_ada[l], g_norm[l], w_in[l], rpb[l], g_q[l], g_k[l], w_out[l])
    y_prompt = rms_norm(xp, g_final)
    y_sample = rms_norm(xs, g_final)
    new_a_k = jnp.stack(new_ak, axis=1)
    new_a_v = jnp.stack(new_av, axis=1)
    new_b_k = jnp.stack(new_bk, axis=1)
    new_b_v = jnp.stack(new_bv, axis=1)
    return (y_prompt, y_sample, new_a_k, new_a_v, new_b_k, new_b_v)
```

```cpp
#include <hip/hip_runtime.h>
#include <hip/hip_cooperative_groups.h>
#include <cstdio>
#include <cstdint>
namespace cg = cooperative_groups;

constexpr int NTOK = 24576, NPR = 8192, DM = 2048, DIN = 6656;
constexpr int DZ = 4096, ZQA = 0, ZGA = 1024, ZQB = 2048, ZGB = 3072;
constexpr size_t OUT_YP = 0, OUT_YS = 16777216, OUT_AK = 50331648, OUT_AV = 58720256, OUT_BK = 67108864, OUT_BV = 69206016;
constexpr size_t WS_H = 0;
constexpr size_t WS_ZQ = WS_H + (size_t)NTOK * DM * 2;
constexpr size_t WS_KV = WS_ZQ + (size_t)NTOK * DZ * 2;
constexpr size_t KAC_E = 0, VAC_E = 8388608, KBC_E = 16777216, VBC_E = 18874368, KAL_E = 20971520, VAL_E = 37748736, KBL_E = 54525952, VBL_E = 58720256, KV_E = 62914560;
constexpr size_t WS_WTIN = WS_KV + KV_E * 2;
constexpr size_t WS_WTOUT = WS_WTIN + (size_t)DIN * DM * 2;
constexpr size_t WS_CACHE = WS_WTOUT + (size_t)DM * DM * 2;
constexpr size_t CAK_E = 0, CAV_E = 4194304, CBK_E = 8388608, CBV_E = 9437184, CACHE_E = 10485760;
constexpr size_t WS_MOD = WS_CACHE + CACHE_E * 2;
constexpr size_t WS_ROPE = WS_MOD + 9 * 6144 * 4;
constexpr size_t WS_END = WS_ROPE + 2 * 64 * 32 * 4;
constexpr int LDS_BYTES = 147456;

struct Params {
  const float *x_prompt, *x_sample, *cak, *cav, *cbk, *cbv, *c, *c_ctx, *w_ada, *b_ada, *g_norm, *w_in, *rpb, *g_q, *g_k, *w_out, *g_final;
  float* out; unsigned char* ws;
};

namespace pg8 {
#define PG8_LAS __attribute__((address_space(3)))
typedef unsigned short bf16_t;
typedef short bf16x8 __attribute__((ext_vector_type(8)));
typedef float f32x4 __attribute__((ext_vector_type(4)));
typedef unsigned u32x4 __attribute__((ext_vector_type(4)));
constexpr int BM = 256, BK = 64, HALF = 128, HTB = HALF * BK * 2  , STAGE_BYTES = 8 * HTB, NXCD = 8, WGM = 8;

__host__ __device__ __forceinline__ int lds_byte(int r, int c) { const int st = (r >> 4) * 2 + (c >> 5), rr = r & 15, cc = c & 31, ob = rr * 64 + cc * 2; return st * 1024 + (ob ^ (((ob >> 9) & 1) << 5)); }
__host__ __device__ __forceinline__ void stage_rc(int b, int& R, int& C) { const int st = b / 1024, sb = b % 1024, swz = sb ^ (((sb >> 9) & 1) << 5); R = (st >> 1) * 16 + swz / 64; C = (st & 1) * 32 + (swz % 64) / 2; }
__host__ __device__ __forceinline__ int perm32(int rho) { const int n = rho >> 4, i = rho & 15; return 8 * (i >> 2) + 4 * n + (i & 3); }

struct Unit { int pm, pn; };
struct Gemm { const bf16_t* A; const bf16_t* Bt; int M, N, K; };

struct StaticOrder {
    int nM, nN, nwg, G, c;
    __host__ __device__ void init(int M, int N, int G_, int c_) { nM = M / BM; nN = N / BM; nwg = nM * nN; G = G_; c = c_; }
    __host__ __device__ bool next(int i, Unit& u) const {
        const long L = (long)i * G + c; if (L >= nwg) return false;
        int wgid = (int)L; { const int q = nwg / NXCD, r = nwg % NXCD, xcd = wgid % NXCD, off = wgid / NXCD; wgid = (xcd < r ? xcd * (q + 1) : r * (q + 1) + (xcd - r) * q) + off; }
        const int nig = WGM * nN, gid = wgid / nig, fm = gid * WGM, gsz = (nM - fm) < WGM ? (nM - fm) : WGM;
        u.pm = fm + ((wgid % nig) % gsz); u.pn = (wgid % nig) / gsz; return true;
    }
    __device__ __forceinline__ void a_ready(const Unit&) const {}
    __device__ __forceinline__ void done(const Unit&) const {}
};

template <class Epi, class Sched>
__device__ __forceinline__ void gemm_phase(PG8_LAS unsigned char* lds, const Gemm g, const Sched& S, const Epi& E) {
    const int tid = threadIdx.x, wid = __builtin_amdgcn_readfirstlane(tid >> 6), lane = tid & 63, wr = wid >> 2, wc = wid & 3, fr = lane & 15, fq = lane >> 4;
    const int K = g.K, nt = K / BK;
    unsigned voffA[2], voffB[2];
#pragma unroll
    for (int i = 0; i < 2; ++i) { int R, C; stage_rc(tid * 16 + i * 8192, R, C); const int Rb = Epi::PERM ? ((R & ~31) + perm32(R & 31)) : R;
        voffA[i] = (unsigned)(R * K + C) * 2u; voffB[i] = (unsigned)(Rb * K + C) * 2u; }
    const size_t kstep = (size_t)(BK * 2);
    const size_t hstep = (size_t)HALF * K * 2;
    const size_t tstep = 2 * hstep;
    const unsigned ldsw = (unsigned)wid * 1024u;
    const int aoff = lds_byte(wr * 64 + fr, fq * 8), boff = lds_byte(wc * 32 + fr, fq * 8);
#define PG8_SA(b, h) (((b) * 2 + (h)) * HTB)
#define PG8_SB(b, h) ((4 + (b) * 2 + (h)) * HTB)
#define PG8_STAGE(bufoff, gbase, voff) do { _Pragma("unroll") for (int _i = 0; _i < 2; ++_i) \
        __builtin_amdgcn_global_load_lds((const unsigned*)((const char*)(gbase) + (voff)[_i]), (PG8_LAS unsigned*)(lds + (bufoff) + ldsw + _i * 8192), 16, 0, 0); } while (0)
#define PG8_LDA(dst, b, h) do { _Pragma("unroll") for (int m = 0; m < 4; ++m) _Pragma("unroll") for (int k = 0; k < 2; ++k) dst[m][k] = *(const PG8_LAS bf16x8*)(lds + PG8_SA(b, h) + aoff + m * 2048 + k * 1024); } while (0)
#define PG8_LDB(dst, b, h) do { _Pragma("unroll") for (int n = 0; n < 2; ++n) _Pragma("unroll") for (int k = 0; k < 2; ++k) dst[n][k] = *(const PG8_LAS bf16x8*)(lds + PG8_SB(b, h) + boff + n * 2048 + k * 1024); } while (0)
#define PG8_MMA(ai, bj, At, Bt) do { __builtin_amdgcn_s_setprio(1); _Pragma("unroll") for (int m = 0; m < 4; ++m) _Pragma("unroll") for (int n = 0; n < 2; ++n) _Pragma("unroll") for (int k = 0; k < 2; ++k) \
        acc[ai][bj][m][n] = __builtin_amdgcn_mfma_f32_16x16x32_bf16(Bt[n][k], At[m][k], acc[ai][bj][m][n], 0, 0, 0); __builtin_amdgcn_s_setprio(0); } while (0)
#define PG8_WAIT_V(n) asm volatile("s_waitcnt vmcnt(" #n ")" ::: "memory")
#define PG8_WAIT_L(n) asm volatile("s_waitcnt lgkmcnt(" #n ")" ::: "memory")
#define PG8_BAR __builtin_amdgcn_s_barrier()
#define PG8_SCHED __builtin_amdgcn_sched_barrier(0)
    Unit cur, nxt; int ui = 0;
    if (!S.next(0, cur)) return;
    f32x4 acc[2][2][4][2];
#pragma unroll
    for (int a = 0; a < 2; ++a)
#pragma unroll
        for (int b = 0; b < 2; ++b)
#pragma unroll
            for (int m = 0; m < 4; ++m)
#pragma unroll
                for (int n = 0; n < 2; ++n) acc[a][b][m][n] = (f32x4){0.f, 0.f, 0.f, 0.f};
    bf16x8 At[4][2], B0[2][2], B1[2][2];
    const char* cA = (const char*)g.A + (size_t)cur.pm * tstep; const char* cB = (const char*)g.Bt + (size_t)cur.pn * tstep;
    S.a_ready(cur);
    PG8_STAGE(PG8_SB(0, 0), cB, voffB); PG8_STAGE(PG8_SA(0, 0), cA, voffA); PG8_STAGE(PG8_SB(0, 1), cB + hstep, voffB); PG8_STAGE(PG8_SA(0, 1), cA + hstep, voffA);
    if (wr == 1) PG8_BAR;
    PG8_WAIT_V(4); PG8_BAR;
    PG8_STAGE(PG8_SB(1, 0), cB + kstep, voffB); PG8_STAGE(PG8_SA(1, 0), cA + kstep, voffA); PG8_STAGE(PG8_SB(1, 1), cB + hstep + kstep, voffB);
    PG8_WAIT_V(6); PG8_BAR;
    for (;;) {
        const bool has_next = S.next(ui + 1, nxt);
        const char* nA = has_next ? (const char*)g.A + (size_t)nxt.pm * tstep : cA; const char* nB = has_next ? (const char*)g.Bt + (size_t)nxt.pn * tstep : cB;
        for (int t = 0; t < nt; t += 2) {
            const bool last = (t == nt - 2);
            const char* a1 = cA + (size_t)(t + 1) * kstep;
            const char* a2 = last ? nA : cA + (size_t)(t + 2) * kstep; const char* b2 = last ? nB : cB + (size_t)(t + 2) * kstep;
            const char* a3 = a2 + kstep; const char* b3 = b2 + kstep;
            if (last && has_next) S.a_ready(nxt);
            PG8_LDB(B0, 0, 0); PG8_SCHED; PG8_LDA(At, 0, 0); PG8_STAGE(PG8_SA(1, 1), a1 + hstep, voffA);
            PG8_WAIT_L(8); PG8_BAR; PG8_WAIT_L(0); PG8_MMA(0, 0, At, B0); PG8_BAR; PG8_SCHED;
            PG8_LDB(B1, 0, 1); PG8_STAGE(PG8_SB(0, 0), b2, voffB);
            PG8_BAR; PG8_WAIT_L(0); PG8_MMA(0, 1, At, B1); PG8_BAR;
            PG8_LDA(At, 0, 1); PG8_STAGE(PG8_SA(0, 0), a2, voffA);
            PG8_BAR; PG8_WAIT_L(0); PG8_MMA(1, 0, At, B0); PG8_BAR; PG8_SCHED;
            PG8_STAGE(PG8_SB(0, 1), b2 + hstep, voffB);
            PG8_WAIT_V(6); PG8_BAR; PG8_MMA(1, 1, At, B1); PG8_BAR;
            PG8_LDB(B0, 1, 0); PG8_SCHED; PG8_LDA(At, 1, 0); PG8_STAGE(PG8_SA(0, 1), a2 + hstep, voffA);
            PG8_WAIT_L(8); PG8_BAR; PG8_WAIT_L(0); PG8_MMA(0, 0, At, B0); PG8_BAR; PG8_SCHED;
            PG8_LDB(B1, 1, 1); PG8_STAGE(PG8_SB(1, 0), b3, voffB);
            PG8_BAR; PG8_WAIT_L(0); PG8_MMA(0, 1, At, B1); PG8_BAR;
            PG8_LDA(At, 1, 1); PG8_STAGE(PG8_SA(1, 0), a3, voffA);
            PG8_BAR; PG8_WAIT_L(0); PG8_MMA(1, 0, At, B0); PG8_BAR; PG8_SCHED;
            PG8_STAGE(PG8_SB(1, 1), b3 + hstep, voffB);
            PG8_WAIT_V(6); PG8_BAR; PG8_MMA(1, 1, At, B1); PG8_BAR;
        }
        if constexpr (!Epi::AFTER_DRAIN) { E(acc, cur, wr, wc, fr, fq); S.done(cur); }
        if (!has_next) break;
#pragma unroll
        for (int a = 0; a < 2; ++a)
#pragma unroll
            for (int b = 0; b < 2; ++b)
#pragma unroll
                for (int m = 0; m < 4; ++m)
#pragma unroll
                    for (int n = 0; n < 2; ++n) acc[a][b][m][n] = (f32x4){0.f, 0.f, 0.f, 0.f};
        cur = nxt; cA = nA; cB = nB; ++ui;
    }
    PG8_WAIT_V(0);
    if (wr == 0) PG8_BAR;
    PG8_BAR;
    if constexpr (Epi::AFTER_DRAIN) { E.fused(acc, cur, wr, wc, fr, fq, lds, wid, lane); S.done(cur); }
#undef PG8_SA
#undef PG8_SB
#undef PG8_STAGE
#undef PG8_LDA
#undef PG8_LDB
#undef PG8_MMA
#undef PG8_WAIT_V
#undef PG8_WAIT_L
#undef PG8_BAR
#undef PG8_SCHED
}
}

typedef unsigned short bf16_t;
typedef float f32x4 __attribute__((ext_vector_type(4)));
typedef float f32x8 __attribute__((ext_vector_type(8)));
typedef unsigned u32x4 __attribute__((ext_vector_type(4)));
typedef unsigned u32x2 __attribute__((ext_vector_type(2)));
#define LAS __attribute__((address_space(3)))
__device__ __forceinline__ unsigned cvtpk(float lo, float hi) { unsigned r; asm volatile("v_cvt_pk_bf16_f32 %0, %1, %2" : "=v"(r) : "v"(lo), "v"(hi)); return r; }
__device__ __forceinline__ float bf2f(bf16_t b) { return __uint_as_float(((unsigned)b) << 16); }
__device__ __forceinline__ void store4bf(bf16_t* p, f32x4 v) { u32x2 w = {cvtpk(v[0], v[1]), cvtpk(v[2], v[3])}; *(u32x2*)p = w; }
__device__ __forceinline__ float siluf(float v) { return v / (1.f + __expf(-v)); }

struct Epi1 {
  static constexpr bool PERM = false, AFTER_DRAIN = false;
  bf16_t* ZQ; bf16_t* KV; float* out; const float* gq; const float* gk; const float* ropeC; const float* ropeS; LAS float* part;
  __device__ __forceinline__ void operator()(const f32x4 (&acc)[2][2][4][2], const pg8::Unit& u, int wr, int wc, int fr, int fq) const {
    const int pn = u.pn, pm = u.pm; const bool ctx = pm < 32;
    const int fbase = 64 * (wc >> 1) + 16 * (wc & 1) + 4 * fq, tok0 = 64 * wr + fr;
    bf16_t* dst; int rs, hs; float* ob = nullptr; int nh = 0, h0 = 0; int kind = 0;
    const int lb = (pm - 32) >> 3, lt = ((pm - 32) & 7) * 256;
    if (pn < 4) { dst = ZQ + (size_t)pm * 256 * DZ + ZQA + pn * 256; rs = DZ; hs = 128; }
    else if (pn < 12 || pn == 20 || pn == 21) {
      size_t ec, el;
      if (pn < 8) { ec = KAC_E; el = KAL_E; nh = 8; h0 = 2 * (pn - 4); if (ctx) ob = out + OUT_AK; }
      else if (pn < 12) { ec = VAC_E; el = VAL_E; nh = 8; h0 = 2 * (pn - 8); if (ctx) ob = out + OUT_AV; }
      else if (pn == 20) { ec = KBC_E; el = KBL_E; nh = 2; h0 = 0; kind = 2; if (ctx) ob = out + OUT_BK; }
      else { ec = VBC_E; el = VBL_E; nh = 2; h0 = 0; if (ctx) ob = out + OUT_BV; }
      rs = 128;
      if (ctx) { dst = KV + ec + ((size_t)(pm * nh + h0) * 256) * 128; hs = 256 * 128; }
      else { dst = KV + el + ((size_t)(lb * nh + h0) * 2048 + lt) * 128; hs = 2048 * 128; }
    }
    else if (pn < 16) { dst = ZQ + (size_t)pm * 256 * DZ + ZGA + (pn - 12) * 256; rs = DZ; hs = 128; kind = 1; }
    else if (pn < 20) { dst = ZQ + (size_t)pm * 256 * DZ + ZQB + (pn - 16) * 256; rs = DZ; hs = 128; kind = 2; }
    else { dst = ZQ + (size_t)pm * 256 * DZ + ZGB + (pn - 22) * 256; rs = DZ; hs = 128; kind = 1; }
    dst += (size_t)tok0 * rs + fbase;
    if (ob) ob += ((size_t)(pm * nh + h0) * 256 + tok0) * 128 + fbase;
    if (kind == 0) {
#pragma unroll
      for (int ai = 0; ai < 2; ++ai)
#pragma unroll
        for (int m = 0; m < 4; ++m) { const int dt = 128 * ai + 16 * m;
#pragma unroll
          for (int bj = 0; bj < 2; ++bj)
#pragma unroll
            for (int n = 0; n < 2; ++n) { const f32x4 v = acc[ai][bj][m][n]; store4bf(dst + (size_t)dt * rs + bj * hs + n * 32, v);
              if (ob) *(f32x4*)(ob + ((size_t)bj * 256 + dt) * 128 + 32 * n) = v; } }
    } else if (kind == 1) {
#pragma unroll
      for (int ai = 0; ai < 2; ++ai)
#pragma unroll
        for (int m = 0; m < 4; ++m) { const int dt = 128 * ai + 16 * m;
#pragma unroll
          for (int bj = 0; bj < 2; ++bj)
#pragma unroll
            for (int n = 0; n < 2; ++n) { f32x4 v = acc[ai][bj][m][n]; v[0] = siluf(v[0]); v[1] = siluf(v[1]); v[2] = siluf(v[2]); v[3] = siluf(v[3]); store4bf(dst + (size_t)dt * rs + bj * hs + n * 32, v); } }
    } else {
#pragma unroll
      for (int bj = 0; bj < 2; ++bj)
#pragma unroll
        for (int ai = 0; ai < 2; ++ai)
#pragma unroll
          for (int m = 0; m < 4; ++m) { const f32x4 a = acc[ai][bj][m][0], b = acc[ai][bj][m][1];
            float s = a[0] * a[0] + a[1] * a[1] + a[2] * a[2] + a[3] * a[3] + b[0] * b[0] + b[1] * b[1] + b[2] * b[2] + b[3] * b[3];
            s += __shfl_xor(s, 16); s += __shfl_xor(s, 32);
            if (fq == 0) part[((wr * 4 + wc) * 16 + (bj * 8 + ai * 4 + m)) * 16 + fr] = s; }
      asm volatile("s_waitcnt lgkmcnt(0)" ::: "memory"); __builtin_amdgcn_s_barrier(); asm volatile("" ::: "memory");
      const float* g = (pn == 20) ? gk : gq;
      const f32x4 g0 = *(const f32x4*)(g + fbase), g1 = *(const f32x4*)(g + fbase + 32);
      const int i0 = 16 * (wc & 1) + 4 * fq;
#pragma unroll
      for (int ai = 0; ai < 2; ++ai)
#pragma unroll
        for (int m = 0; m < 4; ++m) { const int dt = 128 * ai + 16 * m;
          f32x4 cs = {1.f, 1.f, 1.f, 1.f}, sn = {0.f, 0.f, 0.f, 0.f};
          if (!ctx) { const int pos = (wc >> 1) ? (16 * m + fr) : (((pm - 32) & 7) * 4 + 2 * ai + wr);
            cs = *(const f32x4*)(ropeC + pos * 32 + i0); sn = *(const f32x4*)(ropeS + pos * 32 + i0); }
#pragma unroll
          for (int bj = 0; bj < 2; ++bj) { const int idx = (bj * 8 + ai * 4 + m) * 16 + fr;
            const float t = part[(wr * 4 + 0) * 256 + idx] + part[(wr * 4 + 1) * 256 + idx] + part[(wr * 4 + 2) * 256 + idx] + part[(wr * 4 + 3) * 256 + idx];
            const float r = rsqrtf(t * (1.f / 128.f) + 1e-6f);
            const f32x4 x1 = acc[ai][bj][m][0] * r * g0, x2 = acc[ai][bj][m][1] * r * g1;
            const f32x4 o1 = x1 * cs - x2 * sn, o2 = x2 * cs + x1 * sn;
            bf16_t* zp = dst + (size_t)dt * rs + bj * hs; store4bf(zp, o1); store4bf(zp + 32, o2);
            if (ob) { float* op = ob + ((size_t)bj * 256 + dt) * 128; *(f32x4*)op = o1; *(f32x4*)(op + 32) = o2; } } }
    }
  }
};
struct Epi2 {
  static constexpr bool PERM = false, AFTER_DRAIN = false;
  const float* xp; const float* xs; const float* mod; float* out;
  __device__ __forceinline__ void operator()(const f32x4 (&acc)[2][2][4][2], const pg8::Unit& u, int wr, int wc, int fr, int fq) const {
#pragma unroll
    for (int ai = 0; ai < 2; ++ai)
#pragma unroll
      for (int m = 0; m < 4; ++m) { const int row = u.pm * 256 + 128 * ai + 64 * wr + 16 * m + fr;
        const float* xr = row < NPR ? xp + (size_t)row * DM : xs + (size_t)(row - NPR) * DM;
        const int v = row < NPR ? 8 : ((row - NPR) >> 11);
        const float* gt = mod + v * 6144 + 4096; float* orow = out + (size_t)row * DM;
#pragma unroll
        for (int bj = 0; bj < 2; ++bj)
#pragma unroll
          for (int n = 0; n < 2; ++n) { const int col = u.pn * 256 + bj * 128 + wc * 32 + n * 16 + 4 * fq;
            const f32x4 x4 = *(const f32x4*)(xr + col), g4 = *(const f32x4*)(gt + col);
            *(f32x4*)(orow + col) = x4 + g4 * acc[ai][bj][m][n]; } }
  }
};

namespace att {
using bf16x8 = __attribute__((ext_vector_type(8))) short;
using s16x4  = __attribute__((ext_vector_type(4))) short;
using f32x16 = __attribute__((ext_vector_type(16))) float;
constexpr int D = 128, NW = 8, QBLK = 32, KVBLK = 64;
constexpr float SCALE = 0.088388347648318440f;
constexpr float THR = 8.f;
constexpr size_t SHM_V = KVBLK * D * 2, SHM_K = KVBLK * D * 2;
constexpr size_t OFF_WS = 2 * SHM_V + 2 * SHM_K, OFF_BIAS = OFF_WS + NW * 64 * 4;
#define KSWZ(row, colB) ((row) * 256 + ((colB) ^ (((row) & 7) << 4)))
#define SBAR() __builtin_amdgcn_sched_barrier(0)
__device__ __forceinline__ int crow(int r, int hi) { return (r & 3) + 8 * (r >> 2) + 4 * hi; }
__device__ __forceinline__ void partialSM(f32x16& p0, f32x16& p1, float& m_reg, float& mn, float& alpha) {
  constexpr float C = SCALE * 1.4426950408889634f;
  float pmax = p0[0]; for (int r = 1; r < 16; ++r) pmax = fmaxf(pmax, p0[r]); for (int r = 0; r < 16; ++r) pmax = fmaxf(pmax, p1[r]);
  { auto rr = __builtin_amdgcn_permlane32_swap(__float_as_uint(pmax), __float_as_uint(pmax), false, false);
    pmax = fmaxf(__uint_as_float(rr[0]), __uint_as_float(rr[1])); }
  if (__builtin_expect(__all(pmax - m_reg <= THR / SCALE), 1)) { mn = m_reg; alpha = 1.f; }
  else { mn = fmaxf(m_reg, pmax); alpha = __builtin_amdgcn_exp2f((m_reg - mn) * C); m_reg = mn; }
  float mnC = -mn * C;
  for (int r = 0; r < 16; ++r) p0[r] = fmaf(p0[r], C, mnC); for (int r = 0; r < 16; ++r) p1[r] = fmaf(p1[r], C, mnC);
  for (int r = 0; r < 16; ++r) p0[r] = __builtin_amdgcn_exp2f(p0[r]);
}
__device__ __forceinline__ void finishSM(f32x16& p0, f32x16& p1, float alpha, float& l_reg, bf16x8& pa0, bf16x8& pa1, bf16x8& pa2, bf16x8& pa3) {
  for (int r = 0; r < 16; ++r) p1[r] = __builtin_amdgcn_exp2f(p1[r]);
  float ps = 0; for (int r = 0; r < 16; ++r) ps += p0[r]; for (int r = 0; r < 16; ++r) ps += p1[r];
  { auto rr = __builtin_amdgcn_permlane32_swap(__float_as_uint(ps), __float_as_uint(ps), false, false);
    ps = __uint_as_float(rr[0]) + __uint_as_float(rr[1]); }
  l_reg = l_reg * alpha + ps;
#define PK4(P, BASE, OUT) do { unsigned a0 = cvtpk(P[BASE + 0], P[BASE + 1]), a1 = cvtpk(P[BASE + 2], P[BASE + 3]);   \
    unsigned b0 = cvtpk(P[BASE + 4], P[BASE + 5]), b1 = cvtpk(P[BASE + 6], P[BASE + 7]);                              \
    auto r0 = __builtin_amdgcn_permlane32_swap(a0, b0, false, false); auto r1 = __builtin_amdgcn_permlane32_swap(a1, b1, false, false); \
    u32x4 w = {r0[0], r1[0], r0[1], r1[1]}; OUT = *reinterpret_cast<bf16x8*>(&w); } while (0)
  PK4(p0, 0, pa0); PK4(p0, 8, pa1); PK4(p1, 0, pa2); PK4(p1, 8, pa3);
#undef PK4
}
__device__ __forceinline__ void qkt(f32x16& p0, f32x16& p1, const char* Ks, const bf16x8* qr, int r32, int hi) {
  p0 = f32x16{}; p1 = f32x16{};
  for (int d0 = 0; d0 < 8; ++d0) { int cb = (d0 * 16 + hi * 8) * 2;
    bf16x8 b0 = *reinterpret_cast<const bf16x8*>(Ks + KSWZ(r32, cb));
    bf16x8 b1 = *reinterpret_cast<const bf16x8*>(Ks + KSWZ(32 + r32, cb));
    p0 = __builtin_amdgcn_mfma_f32_32x32x16_bf16(b0, qr[d0], p0, 0, 0, 0);
    p1 = __builtin_amdgcn_mfma_f32_32x32x16_bf16(b1, qr[d0], p1, 0, 0, 0); }
}
__device__ __forceinline__ int v_st(int k, int c) { const int kk = (k & ~0xC) | ((k & 4) << 1) | ((k & 8) >> 1); return ((kk >> 3) * 4 + (c >> 5)) * 512 + ((kk & 7) * 32 + (c & 31)) * 2; }
__device__ __forceinline__ int v_rd_base(int lane) { return ((lane & 3) << 3) | (((lane >> 2) & 3) << 6) | (((lane >> 4) & 1) << 5) | (((lane >> 5) & 1) << 8); }
constexpr int v_rd_off(int d0, int ks, int half) { return d0 * 512 + ks * 4096 + half * 2048; }
template <int OFF> __device__ __forceinline__ s16x4 tr_read(int vb) {
  s16x4 r; asm volatile("ds_read_b64_tr_b16 %0, %1 offset:%2" : "=&v"(r) : "v"(vb), "i"(OFF) : "memory"); return r;
}
template <int D0> __device__ __forceinline__ void pv_one(f32x16& od, int vb, bf16x8 pa0, bf16x8 pa1, bf16x8 pa2, bf16x8 pa3) {
  const s16x4 l0 = tr_read<v_rd_off(D0, 0, 0)>(vb), h0 = tr_read<v_rd_off(D0, 0, 1)>(vb), l1 = tr_read<v_rd_off(D0, 1, 0)>(vb), h1 = tr_read<v_rd_off(D0, 1, 1)>(vb);
  const s16x4 l2 = tr_read<v_rd_off(D0, 2, 0)>(vb), h2 = tr_read<v_rd_off(D0, 2, 1)>(vb), l3 = tr_read<v_rd_off(D0, 3, 0)>(vb), h3 = tr_read<v_rd_off(D0, 3, 1)>(vb);
  asm volatile("s_waitcnt lgkmcnt(0)" ::: "memory"); SBAR();
#define PK(L, H) (bf16x8){L[0], L[1], L[2], L[3], H[0], H[1], H[2], H[3]}
  od = __builtin_amdgcn_mfma_f32_32x32x16_bf16(pa0, PK(l0, h0), od, 0, 0, 0);
  od = __builtin_amdgcn_mfma_f32_32x32x16_bf16(pa1, PK(l1, h1), od, 0, 0, 0);
  od = __builtin_amdgcn_mfma_f32_32x32x16_bf16(pa2, PK(l2, h2), od, 0, 0, 0);
  od = __builtin_amdgcn_mfma_f32_32x32x16_bf16(pa3, PK(l3, h3), od, 0, 0, 0);
#undef PK
}
__device__ __forceinline__ void pv_d0(f32x16* o, int vb, bf16x8 pa0, bf16x8 pa1, bf16x8 pa2, bf16x8 pa3) {
  pv_one<0>(o[0], vb, pa0, pa1, pa2, pa3); pv_one<1>(o[1], vb, pa0, pa1, pa2, pa3); pv_one<2>(o[2], vb, pa0, pa1, pa2, pa3); pv_one<3>(o[3], vb, pa0, pa1, pa2, pa3);
}
template <int MODE> __device__ __forceinline__ void nb_hook(f32x16& p0, f32x16& p1, int t, int T0, int kr0, int rw, int qc, int hi, const float* biasS) {
  if constexpr (MODE == 1) {
    if (t >= T0) {
      const int kr = kr0 + (t - T0), rs = min(max(rw - 4, 0), 24);
      if (kr < rs || kr >= rs + 8) {
#pragma unroll
        for (int r = 0; r < 16; ++r) { p0[r] = -1e30f; p1[r] = -1e30f; }
      } else {
        const float* bt = biasS + (kr - rw + 7) * 128 + (4 * hi - qc + 63); const int cv = 4 * hi - min(max(qc - 8, 0), 48);
#pragma unroll
        for (int r = 0; r < 16; ++r) { const int kc = (r & 3) + 8 * (r >> 2);
          p0[r] = ((unsigned)(kc + cv) < 16u) ? p0[r] + bt[kc] : -1e30f;
          p1[r] = ((unsigned)(kc + 32 + cv) < 16u) ? p1[r] + bt[kc + 32] : -1e30f;
          if ((r & 3) == 3) SBAR(); }
      }
    }
  }
}

template <int MODE>
__device__ __forceinline__ void attn_item(const bf16_t* __restrict__ Qb, const bf16_t* __restrict__ K0, const bf16_t* __restrict__ V0, int T0,
                                          const bf16_t* __restrict__ K1, const bf16_t* __restrict__ V1, int NT,
                                          const bf16_t* __restrict__ Gb, bf16_t* __restrict__ Ob, int kr0, int rw0, char* lds) {
  const int tid = threadIdx.x, wid = __builtin_amdgcn_readfirstlane(tid >> 6), lane = tid & 63, r32 = lane & 31, hi = lane >> 5;
  char* V_lds = lds; char* K_lds = lds + 2 * SHM_V;
  float* ws = (float*)(lds + OFF_WS) + wid * 64; float* li_l = ws; float* al_l = ws + 32;
  const float* biasS = (const float*)(lds + OFF_BIAS);
  const int rw = rw0 + (wid >> 1), qc = (wid & 1) * 32 + r32;
  float m_reg = -1e30f, l_reg = 0; f32x16 o[4] = {}; bf16x8 qr[8];
  const bf16_t* Qw = Qb + (long)(wid * QBLK + r32) * DZ + hi * 8;
#pragma unroll
  for (int d0 = 0; d0 < 8; ++d0) qr[d0] = *reinterpret_cast<const bf16x8*>(Qw + d0 * 16);
  const int sr = tid >> 4, sc = (tid & 15) * 8, vst0 = v_st(sr, sc), vst1 = v_st(32 + sr, sc);
  const int vb0 = (int)(uintptr_t)V_lds + v_rd_base(lane); const int soff = sr * D + sc;
  struct { bf16x8 vs0, vs1, ks0, ks1; } sr_[1];
#define SLOAD(i, t) do { const int _t = (t); const bool _s1 = _t >= T0; const int _tt = _s1 ? _t - T0 : _t; \
    const bf16_t* _kb = (_s1 ? K1 : K0) + (long)_tt * (KVBLK * D); const bf16_t* _vb = (_s1 ? V1 : V0) + (long)_tt * (KVBLK * D); \
    sr_[i].vs0 = *reinterpret_cast<const bf16x8*>(_vb + soff); sr_[i].vs1 = *reinterpret_cast<const bf16x8*>(_vb + soff + 32 * D); \
    sr_[i].ks0 = *reinterpret_cast<const bf16x8*>(_kb + soff); sr_[i].ks1 = *reinterpret_cast<const bf16x8*>(_kb + soff + 32 * D); } while (0)
#define SWRITE(b, i) do { *(bf16x8*)(V_lds + (b) * SHM_V + vst0) = sr_[i].vs0;          \
    *(bf16x8*)(V_lds + (b) * SHM_V + vst1) = sr_[i].vs1; int kc = sc * 2;               \
    *(bf16x8*)(K_lds + (b) * SHM_K + KSWZ(sr, kc)) = sr_[i].ks0;                       \
    *(bf16x8*)(K_lds + (b) * SHM_K + KSWZ(32 + sr, kc)) = sr_[i].ks1; } while (0)
#define SWAIT() asm volatile("s_waitcnt vmcnt(0)" ::: "memory")
#define RESC(a) do { if (__any((a) < 1.f)) { if (hi == 0) al_l[r32] = (a); asm volatile("s_waitcnt lgkmcnt(0)" ::: "memory"); \
    for (int d = 0; d < 4; ++d) for (int r = 0; r < 16; ++r) o[d][r] *= al_l[crow(r, hi)]; } } while (0)
  f32x16 pA0, pA1, pB0, pB1; float mnA, mnB, alA, alB; bf16x8 pa0, pa1, pa2, pa3;
  constexpr int SE = 0, SO = 0;
  SLOAD(SE, 0); asm volatile("s_waitcnt vmcnt(0)" ::: "memory"); SWRITE(0, SE); __syncthreads();
  qkt(pA0, pA1, K_lds, qr, r32, hi); nb_hook<MODE>(pA0, pA1, 0, T0, kr0, rw, qc, hi, biasS); partialSM(pA0, pA1, m_reg, mnA, alA);
  SLOAD(SO, 1);
  SWAIT(); SWRITE(1, SO); __syncthreads();
  for (int j = 1; j + 1 < NT; j += 2) {
    SBAR(); qkt(pB0, pB1, K_lds + SHM_K, qr, r32, hi);
    finishSM(pA0, pA1, alA, l_reg, pa0, pa1, pa2, pa3); SBAR();
    SLOAD(SO, j + 1); SBAR();
    pv_d0(o, vb0, pa0, pa1, pa2, pa3); nb_hook<MODE>(pB0, pB1, j, T0, kr0, rw, qc, hi, biasS); partialSM(pB0, pB1, m_reg, mnB, alB);
    __syncthreads(); SWAIT(); SWRITE(0, SE);
    RESC(alB); __syncthreads();
    SBAR(); qkt(pA0, pA1, K_lds, qr, r32, hi);
    finishSM(pB0, pB1, alB, l_reg, pa0, pa1, pa2, pa3); SBAR();
    SLOAD(SE, j + 2); SBAR();
    pv_d0(o, vb0 + (int)SHM_V, pa0, pa1, pa2, pa3); nb_hook<MODE>(pA0, pA1, j + 1, T0, kr0, rw, qc, hi, biasS); partialSM(pA0, pA1, m_reg, mnA, alA);
    __syncthreads(); SWAIT(); SWRITE(1, SO);
    RESC(alA); __syncthreads();
  }
  SBAR(); qkt(pB0, pB1, K_lds + SHM_K, qr, r32, hi);
  finishSM(pA0, pA1, alA, l_reg, pa0, pa1, pa2, pa3); SBAR();
  pv_d0(o, vb0, pa0, pa1, pa2, pa3); nb_hook<MODE>(pB0, pB1, NT - 1, T0, kr0, rw, qc, hi, biasS); partialSM(pB0, pB1, m_reg, mnB, alB);
  __syncthreads(); RESC(alB);
  finishSM(pB0, pB1, alB, l_reg, pa0, pa1, pa2, pa3); SBAR();
  pv_d0(o, vb0 + (int)SHM_V, pa0, pa1, pa2, pa3);
  if (hi == 0) li_l[r32] = l_reg; asm volatile("s_waitcnt lgkmcnt(0)" ::: "memory");
  float rli[16];
#pragma unroll
  for (int r = 0; r < 16; ++r) rli[r] = __builtin_amdgcn_rcpf(li_l[crow(r, hi)]);
  __syncthreads();
  char* obase = lds + wid * 8192;
#pragma unroll
  for (int r = 0; r < 16; ++r) { const int orow = crow(r, hi);
#pragma unroll
    for (int d0 = 0; d0 < 4; ++d0) *(bf16_t*)(obase + orow * 256 + (d0 * 32 + r32) * 2) = (bf16_t)(cvtpk(o[d0][r] * rli[r], 0.f) & 0xffffu); }
  asm volatile("s_waitcnt lgkmcnt(0)" ::: "memory");
  const bf16_t* Gw = Gb + (long)(wid * QBLK) * DZ; bf16_t* Ow = Ob + (long)(wid * QBLK) * DM;
#pragma unroll 2
  for (int i = 0; i < 8; ++i) { const int c = lane + 64 * i, row = c >> 4, cc = (c & 15) * 8;
    const u32x4 ov = *(const u32x4*)(obase + row * 256 + cc * 2); const u32x4 gv = *(const u32x4*)(Gw + row * DZ + cc);
    u32x4 w;
#pragma unroll
    for (int q = 0; q < 4; ++q) { const float a0 = __uint_as_float(ov[q] << 16) * __uint_as_float(gv[q] << 16), a1 = __uint_as_float(ov[q] & 0xffff0000u) * __uint_as_float(gv[q] & 0xffff0000u); w[q] = cvtpk(a0, a1); }
    *(u32x4*)(Ow + row * DM + cc) = w; }
#undef SLOAD
#undef SWRITE
#undef SWAIT
#undef RESC
}
}

__device__ __forceinline__ float wave_sum(float v) {
#pragma unroll
  for (int o = 32; o >= 1; o >>= 1) v += __shfl_xor(v, o);
  return v;
}
constexpr int P0_GEMV = 192, P0_WIN = 1664, P0_WOUT = 512, P0_CACHE = 320, P0_TOTAL = P0_GEMV + P0_WIN + P0_WOUT + P0_CACHE + 1;
__device__ __forceinline__ void p0_gemv(const Params& p, int ci, char* shm) {
  const int tid = threadIdx.x; float* sc = (float*)shm;
  for (int i = tid; i < 9 * 2048; i += 512) { const int v = i >> 11, k = i & 2047; const float cv = v < 8 ? p.c[v * 2048 + k] : p.c_ctx[k]; sc[i] = siluf(cv); }
  __syncthreads();
  const int c4 = tid & 7, kg = tid >> 3;
  f32x4 acc[9];
#pragma unroll
  for (int v = 0; v < 9; ++v) acc[v] = (f32x4){0.f, 0.f, 0.f, 0.f};
  const float* wp = p.w_ada + (size_t)kg * 6144 + ci * 32 + c4 * 4;
#pragma unroll 8
  for (int i = 0; i < 32; ++i) { const f32x4 w = *(const f32x4*)(wp + (size_t)i * 64 * 6144); const int k = kg + 64 * i;
#pragma unroll
    for (int v = 0; v < 9; ++v) acc[v] += w * sc[v * 2048 + k]; }
  __syncthreads();
  float* red = (float*)shm;
#pragma unroll
  for (int v = 0; v < 9; ++v) *(f32x4*)(red + (kg * 9 + v) * 32 + c4 * 4) = acc[v];
  __syncthreads();
  if (tid < 288) { const int v = tid >> 5, cc = tid & 31; float s = 0.f; for (int g = 0; g < 64; ++g) s += red[(g * 9 + v) * 32 + cc];
    const int col = ci * 32 + cc; ((float*)(p.ws + WS_MOD))[v * 6144 + col] = s + p.b_ada[col]; }
  __syncthreads();
}
__device__ __forceinline__ void p0_transpose(const float* __restrict__ src, int ncols, bf16_t* __restrict__ dst, int hb, int kc, bool perm, char* shm) {
  const int tid = threadIdx.x; float* tl = (float*)shm;
#pragma unroll
  for (int i = 0; i < 4; ++i) { const int idx = tid + 512 * i, kk = idx >> 5, c4 = idx & 31;
    const f32x4 w = *(const f32x4*)(src + (size_t)(kc * 64 + kk) * ncols + hb * 128 + c4 * 4);
    float* t = tl + kk * 129 + c4 * 4; t[0] = w[0]; t[1] = w[1]; t[2] = w[2]; t[3] = w[3]; }
  __syncthreads();
#pragma unroll
  for (int i = 0; i < 2; ++i) { const int task = tid + 512 * i, o = task & 7, s = task >> 3;
    const int f = perm ? ((s & ~0x30) | ((s & 0x10) << 1) | ((s & 0x20) >> 1)) : s;
    const float* t = tl + (8 * o) * 129 + f;
    u32x4 w = {cvtpk(t[0], t[129]), cvtpk(t[2 * 129], t[3 * 129]), cvtpk(t[4 * 129], t[5 * 129]), cvtpk(t[6 * 129], t[7 * 129])};
    *(u32x4*)(dst + (size_t)(hb * 128 + s) * 2048 + kc * 64 + 8 * o) = w; }
  __syncthreads();
}
__device__ __forceinline__ void p0_cache(const Params& p, int item) {
  bf16_t* dst = (bf16_t*)(p.ws + WS_CACHE);
#pragma unroll
  for (int i = 0; i < 8; ++i) { const size_t g = (size_t)item * 4096 + threadIdx.x + 512 * i;
    const float* src; size_t gl;
    if (g < CAV_E / 8) { src = p.cak; gl = g; } else if (g < CBK_E / 8) { src = p.cav; gl = g - CAV_E / 8; } else if (g < CBV_E / 8) { src = p.cbk; gl = g - CBK_E / 8; } else { src = p.cbv; gl = g - CBV_E / 8; }
    const f32x8 x = *(const f32x8*)(src + gl * 8);
    u32x4 w = {cvtpk(x[0], x[1]), cvtpk(x[2], x[3]), cvtpk(x[4], x[5]), cvtpk(x[6], x[7])};
    *(u32x4*)(dst + g * 8) = w; }
}
__device__ __forceinline__ void p0_rope(const Params& p) {
  float* rc = (float*)(p.ws + WS_ROPE); float* rs = rc + 64 * 32;
#pragma unroll 1
  for (int q = 0; q < 4; ++q) { const int e = threadIdx.x * 4 + q, pos = e >> 5, i = e & 31;
    double f = 1.0; for (int j = 0; j < i; ++j) f *= 0.7498942093324559;
    const double ang = (double)pos * f; const double kk = __builtin_rint(ang * 0.15915494309189535); const double r = ang - kk * 6.283185307179586, r2 = r * r;
    double s = r, c = 1.0, ts = r, tc = 1.0;
#pragma unroll 1
    for (int n = 1; n <= 15; ++n) { tc *= -r2 / (double)((2 * n - 1) * (2 * n)); c += tc; ts *= -r2 / (double)((2 * n) * (2 * n + 1)); s += ts; }
    rc[e] = (float)c; rs[e] = (float)s; }
}
__device__ __forceinline__ void phase0(const Params& p, char* shm) {
  for (int it = blockIdx.x; it < P0_TOTAL; it += gridDim.x) {
    if (it < P0_GEMV) p0_gemv(p, it, shm);
    else if (it < P0_GEMV + P0_WIN) { const int i = it - P0_GEMV; p0_transpose(p.w_in, DIN, (bf16_t*)(p.ws + WS_WTIN), i >> 5, i & 31, true, shm); }
    else if (it < P0_GEMV + P0_WIN + P0_WOUT) { const int i = it - P0_GEMV - P0_WIN; p0_transpose(p.w_out, DM, (bf16_t*)(p.ws + WS_WTOUT), i >> 5, i & 31, false, shm); }
    else if (it < P0_TOTAL - 1) p0_cache(p, it - (P0_GEMV + P0_WIN + P0_WOUT));
    else p0_rope(p);
  }
}
__device__ __forceinline__ void phase1(const Params& p) {
  const int wid = threadIdx.x >> 6, lane = threadIdx.x & 63; const float* mod = (const float*)(p.ws + WS_MOD); bf16_t* H = (bf16_t*)(p.ws + WS_H);
  for (int row = blockIdx.x * 8 + wid; row < NTOK; row += gridDim.x * 8) {
    const float* xr = row < NPR ? p.x_prompt + (size_t)row * DM : p.x_sample + (size_t)(row - NPR) * DM;
    const int v = row < NPR ? 8 : ((row - NPR) >> 11);
    f32x4 x[8]; float ss = 0.f;
#pragma unroll
    for (int i = 0; i < 8; ++i) { x[i] = *(const f32x4*)(xr + (lane + 64 * i) * 4); ss += x[i][0] * x[i][0] + x[i][1] * x[i][1] + x[i][2] * x[i][2] + x[i][3] * x[i][3]; }
    ss = wave_sum(ss); const float rstd = rsqrtf(ss * (1.f / DM) + 1e-6f);
#pragma unroll
    for (int i = 0; i < 8; ++i) { const int col = (lane + 64 * i) * 4;
      const f32x4 g = *(const f32x4*)(p.g_norm + col), sh = *(const f32x4*)(mod + v * 6144 + col), scl = *(const f32x4*)(mod + v * 6144 + 2048 + col);
      const f32x4 h = (x[i] * rstd * g) * (scl + 1.f) + sh;
      store4bf(H + (size_t)row * DM + col, h); }
  }
}
__device__ __forceinline__ void phase5(const Params& p) {
  const int wid = threadIdx.x >> 6, lane = threadIdx.x & 63;
  for (int row = blockIdx.x * 8 + wid; row < NTOK; row += gridDim.x * 8) {
    float* yr = p.out + (size_t)row * DM;
    f32x4 x[8]; float ss = 0.f;
#pragma unroll
    for (int i = 0; i < 8; ++i) { x[i] = *(const f32x4*)(yr + (lane + 64 * i) * 4); ss += x[i][0] * x[i][0] + x[i][1] * x[i][1] + x[i][2] * x[i][2] + x[i][3] * x[i][3]; }
    ss = wave_sum(ss); const float rstd = rsqrtf(ss * (1.f / DM) + 1e-6f);
#pragma unroll
    for (int i = 0; i < 8; ++i) { const int col = (lane + 64 * i) * 4; const f32x4 g = *(const f32x4*)(p.g_final + col); *(f32x4*)(yr + col) = x[i] * rstd * g; }
  }
}
__device__ __forceinline__ void phase3(const Params& p, char* shm) {
  const bf16_t* ZQ = (const bf16_t*)(p.ws + WS_ZQ); const bf16_t* KV = (const bf16_t*)(p.ws + WS_KV); bf16_t* G = (bf16_t*)(p.ws + WS_H); const bf16_t* CB = (const bf16_t*)(p.ws + WS_CACHE);
  for (int it = blockIdx.x; it < 1536; it += gridDim.x) {
    __syncthreads();
    const bf16_t *Q, *K0, *V0, *K1, *V1, *Gt; bf16_t* O; int T0, NT, kr0 = 0, rw0 = 0;
    if (it < 512) { const int b = it >> 6, hq = (it >> 3) & 7, qb = it & 7, kvh = hq >> 2; const size_t rq = (size_t)NPR + b * 2048 + qb * 256;
      Q = ZQ + rq * DZ + ZQB + hq * 128; Gt = ZQ + rq * DZ + ZGB + hq * 128; O = G + rq * DM + 1024 + hq * 128;
      K0 = KV + KBL_E + (size_t)(b * 2 + kvh) * 2048 * 128; V0 = KV + VBL_E + (size_t)(b * 2 + kvh) * 2048 * 128; T0 = 32;
      K1 = CB + CBK_E + (size_t)(b * 2 + kvh) * 512 * 128; V1 = CB + CBV_E + (size_t)(b * 2 + kvh) * 512 * 128; NT = 40;
    } else if (it < 1024) { const int i = it - 512, b = i >> 6, h = (i >> 3) & 7, rg = i & 7; const size_t rq = (size_t)NPR + b * 2048 + rg * 256;
      const int lo = min(max(4 * rg - 4, 0), 24), nb = (rg == 0 || rg == 7) ? 8 : 12;
      Q = ZQ + rq * DZ + ZQA + h * 128; Gt = ZQ + rq * DZ + ZGA + h * 128; O = G + rq * DM + h * 128;
      K0 = CB + CAK_E + (size_t)(b * 8 + h) * 512 * 128; V0 = CB + CAV_E + (size_t)(b * 8 + h) * 512 * 128; T0 = 8;
      K1 = KV + KAL_E + ((size_t)(b * 8 + h) * 2048 + lo * 64) * 128; V1 = KV + VAL_E + ((size_t)(b * 8 + h) * 2048 + lo * 64) * 128; NT = 8 + nb; kr0 = lo; rw0 = 4 * rg;
      float* biasS = (float*)(shm + att::OFF_BIAS);
      if (threadIdx.x < 465) { const int ro = threadIdx.x / 31, co = threadIdx.x - ro * 31; biasS[ro * 128 + 48 + co] = p.rpb[h * 465 + threadIdx.x] * (1.f / att::SCALE); }
    } else if (it < 1280) { const int i = it - 1024, b = i >> 3, h = i & 7; const size_t r0 = (size_t)b * 256;
      Q = ZQ + r0 * DZ + ZQA + h * 128; Gt = ZQ + r0 * DZ + ZGA + h * 128; O = G + r0 * DM + h * 128;
      K0 = KV + KAC_E + (size_t)(b * 8 + h) * 256 * 128; V0 = KV + VAC_E + (size_t)(b * 8 + h) * 256 * 128; T0 = 4; K1 = K0; V1 = V0; NT = 4;
    } else { const int i = it - 1280, b = i >> 3, hq = i & 7, kvh = hq >> 2; const size_t r0 = (size_t)b * 256;
      Q = ZQ + r0 * DZ + ZQB + hq * 128; Gt = ZQ + r0 * DZ + ZGB + hq * 128; O = G + r0 * DM + 1024 + hq * 128;
      K0 = KV + KBC_E + (size_t)(b * 2 + kvh) * 256 * 128; V0 = KV + VBC_E + (size_t)(b * 2 + kvh) * 256 * 128; T0 = 4; K1 = K0; V1 = V0; NT = 4;
    }
    if (it >= 512 && it < 1024) att::attn_item<1>(Q, K0, V0, T0, K1, V1, NT, Gt, O, kr0, rw0, shm);
    else att::attn_item<0>(Q, K0, V0, T0, K1, V1, NT, Gt, O, 0, 0, shm);
  }
}

__global__ void __launch_bounds__(512, 2) hymba_megakernel(Params p) {
  extern __shared__ __attribute__((aligned(16))) unsigned char shm[];
  cg::grid_group grid = cg::this_grid();
#ifndef PH
#define PH 0x3f
#endif
  if (PH & 1) phase0(p, (char*)shm);
  grid.sync();
  if (PH & 2) phase1(p);
  grid.sync();
  if (PH & 4) { pg8::Gemm g; g.A = (const bf16_t*)(p.ws + WS_H); g.Bt = (const bf16_t*)(p.ws + WS_WTIN); g.M = NTOK; g.N = DIN; g.K = DM;
    pg8::StaticOrder S; S.init(g.M, g.N, (int)gridDim.x, (int)blockIdx.x);
    Epi1 E; E.ZQ = (bf16_t*)(p.ws + WS_ZQ); E.KV = (bf16_t*)(p.ws + WS_KV); E.out = p.out; E.gq = p.g_q; E.gk = p.g_k; E.ropeC = (const float*)(p.ws + WS_ROPE); E.ropeS = E.ropeC + 64 * 32;
    E.part = (LAS float*)((LAS unsigned char*)shm + pg8::STAGE_BYTES);
    pg8::gemm_phase<Epi1, pg8::StaticOrder>((LAS unsigned char*)shm, g, S, E); }
  grid.sync();
  if (PH & 8) phase3(p, (char*)shm);
  grid.sync();
  if (PH & 16) { pg8::Gemm g; g.A = (const bf16_t*)(p.ws + WS_H); g.Bt = (const bf16_t*)(p.ws + WS_WTOUT); g.M = NTOK; g.N = DM; g.K = DM;
    pg8::StaticOrder S; S.init(g.M, g.N, (int)gridDim.x, (int)blockIdx.x);
    Epi2 E; E.xp = p.x_prompt; E.xs = p.x_sample; E.mod = (const float*)(p.ws + WS_MOD); E.out = p.out;
    pg8::gemm_phase<Epi2, pg8::StaticOrder>((LAS unsigned char*)shm, g, S, E); }
  grid.sync();
  if (PH & 32) phase5(p);
}

extern "C" void kernel_launch(void* const* d_in, const int* in_sizes, int n_in, void* d_out, int out_size, void* d_ws, size_t ws_size, hipStream_t stream) {
  static int grid_blocks = 0;
  if (!grid_blocks) {
    if (ws_size < WS_END) { fprintf(stderr, "kernel_launch: workspace too small: %zu < %zu\n", ws_size, (size_t)WS_END); return; }
    if (hipFuncSetAttribute((const void*)hymba_megakernel, hipFuncAttributeMaxDynamicSharedMemorySize, LDS_BYTES) != hipSuccess) { fprintf(stderr, "kernel_launch: hipFuncSetAttribute failed\n"); return; }
    int dev = 0, cus = 0, per_cu = 0;
    (void)hipGetDevice(&dev); (void)hipDeviceGetAttribute(&cus, hipDeviceAttributeMultiprocessorCount, dev);
    (void)hipOccupancyMaxActiveBlocksPerMultiprocessor(&per_cu, hymba_megakernel, 512, LDS_BYTES);
    if (per_cu < 1 || cus < 1) { fprintf(stderr, "kernel_launch: occupancy query says %d blocks/CU on %d CUs\n", per_cu, cus); return; }
    grid_blocks = cus;
  }
  Params p{};
  p.x_prompt = (const float*)d_in[0]; p.x_sample = (const float*)d_in[1]; p.cak = (const float*)d_in[2]; p.cav = (const float*)d_in[3]; p.cbk = (const float*)d_in[4]; p.cbv = (const float*)d_in[5];
  p.c = (const float*)d_in[6]; p.c_ctx = (const float*)d_in[7]; p.w_ada = (const float*)d_in[8]; p.b_ada = (const float*)d_in[9]; p.g_norm = (const float*)d_in[10]; p.w_in = (const float*)d_in[11];
  p.rpb = (const float*)d_in[12]; p.g_q = (const float*)d_in[13]; p.g_k = (const float*)d_in[14]; p.w_out = (const float*)d_in[15]; p.g_final = (const float*)d_in[16];
  p.out = (float*)d_out; p.ws = (unsigned char*)d_ws;
  void* args[] = {&p};
  hipError_t e = hipLaunchCooperativeKernel((const void*)hymba_megakernel, dim3(grid_blocks), dim3(512), args, LDS_BYTES, stream);
  if (e != hipSuccess) fprintf(stderr, "cooperative launch failed: %s (grid %d)\n", hipGetErrorString(e), grid_blocks);
}
```

```cpp
#include <hip/hip_runtime.h>
#include <hip/hip_cooperative_groups.h>
#include <cstdio>
#include <cstdint>
namespace cg = cooperative_groups;

constexpr int NTOK = 24576, NPR = 8192, DM = 2048, DIN = 6656;
constexpr int DZ = 4224, LDH = 2112,     ZQA = 0, ZGA = 1024, ZQB = 2048, ZGB = 3072;
constexpr size_t OUT_YP = 0, OUT_YS = 16777216, OUT_AK = 50331648, OUT_AV = 58720256, OUT_BK = 67108864, OUT_BV = 69206016;
constexpr size_t WS_H = 0;
constexpr size_t WS_ZQ = WS_H + (size_t)NTOK * LDH * 2;
constexpr size_t WS_KV = WS_ZQ + (size_t)NTOK * DZ * 2;
constexpr size_t KAC_E = 0, VAC_E = 8388608, KBC_E = 16777216, VBC_E = 18874368, KAL_E = 20971520, VAL_E = 37748736, KBL_E = 54525952, VBL_E = 58720256, KV_E = 62914560;
constexpr size_t WS_WTIN = WS_KV + KV_E * 2;
constexpr size_t WS_WTOUT = WS_WTIN + (size_t)DIN * LDH * 2;
constexpr size_t WS_CACHE = WS_WTOUT + (size_t)DM * LDH * 2;
constexpr size_t CAK_E = 0, CAV_E = 4194304, CBK_E = 8388608, CBV_E = 9437184, CACHE_E = 10485760;
constexpr size_t WS_MOD = WS_CACHE + CACHE_E * 2;
constexpr size_t WS_ROPE = WS_MOD + 9 * 6144 * 4;
constexpr size_t WS_BAR = WS_ROPE + 2 * 64 * 32 * 4;
constexpr size_t WS_CTR = WS_BAR + 3456 * 4;
constexpr size_t WS_END = WS_CTR + 256;
constexpr int LDS_BYTES = 147456;

struct Params {
  const float *x_prompt, *x_sample, *cak, *cav, *cbk, *cbv, *c, *c_ctx, *w_ada, *b_ada, *g_norm, *w_in, *rpb, *g_q, *g_k, *w_out, *g_final;
  float* out; unsigned char* ws;
};

namespace pg8 {
#define PG8_LAS __attribute__((address_space(3)))
typedef unsigned short bf16_t;
typedef short bf16x8 __attribute__((ext_vector_type(8)));
typedef float f32x4 __attribute__((ext_vector_type(4)));
typedef unsigned u32x4 __attribute__((ext_vector_type(4)));
constexpr int BM = 256, BK = 64, HALF = 128, HTB = HALF * BK * 2  , STAGE_BYTES = 8 * HTB, NXCD = 8, WGM = 8;

__host__ __device__ __forceinline__ int lds_byte(int r, int c) { const int st = (r >> 4) * 2 + (c >> 5), rr = r & 15, cc = c & 31, ob = rr * 64 + cc * 2; return st * 1024 + (ob ^ (((ob >> 9) & 1) << 5)); }
__host__ __device__ __forceinline__ void stage_rc(int b, int& R, int& C) { const int st = b / 1024, sb = b % 1024, swz = sb ^ (((sb >> 9) & 1) << 5); R = (st >> 1) * 16 + swz / 64; C = (st & 1) * 32 + (swz % 64) / 2; }
__host__ __device__ __forceinline__ int perm32(int rho) { const int n = rho >> 4, i = rho & 15; return 8 * (i >> 2) + 4 * n + (i & 3); }

struct Unit { int pm, pn; };
struct Gemm { const bf16_t* A; const bf16_t* Bt; int M, N, K, ld; };

struct StaticOrder {
    int nM, nN, nwg, G, c, spread;
    __host__ __device__ void init(int M, int N, int G_, int c_) { nM = M / BM; nN = N / BM; nwg = nM * nN; G = G_; c = c_; spread = 0; }
    __host__ __device__ bool next(int i, Unit& u) const {
        const long L = (long)i * G + c; if (L >= nwg) return false;
        int wgid = (int)L; { const int q = nwg / NXCD, r = nwg % NXCD, xcd = wgid % NXCD, off = wgid / NXCD; wgid = (xcd < r ? xcd * (q + 1) : r * (q + 1) + (xcd - r) * q) + off; }
        const int nig = WGM * nN, gid = wgid / nig, fm = gid * WGM, gsz = (nM - fm) < WGM ? (nM - fm) : WGM;
        u.pn = (wgid % nig) / gsz;
        if (!spread) { u.pm = fm + ((wgid % nig) % gsz); return true; }
        const int lr = fm + ((wgid % nig) % gsz + u.pn) % gsz;
        if (nM != 96) { u.pm = lr; return true; }
        const int blk = lr / 24, o = lr - 24 * blk;
        u.pm = o < 4 ? 8 * blk + o : (o >= 16 && o < 20) ? 8 * blk + 4 + (o - 16) : 32 + 16 * blk + (o < 16 ? o - 4 : o - 8);
        return true;
    }
    __device__ __forceinline__ void a_ready(const Unit&) const {}
    __device__ __forceinline__ void done(const Unit&) const {}
};

template <class Epi, class Sched>
__device__ __forceinline__ void gemm_phase(PG8_LAS unsigned char* lds, const Gemm g, const Sched& S, const Epi& E) {
    int tid = threadIdx.x; asm volatile("" : "+v"(tid)); const int wid = __builtin_amdgcn_readfirstlane(tid >> 6), lane = tid & 63, wr = wid >> 2, wc = wid & 3, fr = lane & 15, fq = lane >> 4;
    const int K = g.K, nt = K / BK, LD = g.ld;
    unsigned voffA[2], voffB[2];
#pragma unroll
    for (int i = 0; i < 2; ++i) { int R, C; stage_rc(tid * 16 + i * 8192, R, C); const int Rb = Epi::PERM ? ((R & ~31) + perm32(R & 31)) : R;
        voffA[i] = (unsigned)(R * LD + C) * 2u; voffB[i] = (unsigned)(Rb * LD + C) * 2u; }
    const size_t kstep = (size_t)(BK * 2);
    const size_t hstep = (size_t)HALF * LD * 2;
    const size_t tstep = 2 * hstep;
    const unsigned ldsw = (unsigned)wid * 1024u;
    const int aoff = lds_byte(wr * 64 + fr, fq * 8), boff = lds_byte(wc * 32 + fr, fq * 8);
#define PG8_SA(b, h) (((b) * 2 + (h)) * HTB)
#define PG8_SB(b, h) ((4 + (b) * 2 + (h)) * HTB)
#define PG8_STAGE(bufoff, gbase, voff) do { _Pragma("unroll") for (int _i = 0; _i < 2; ++_i) \
        __builtin_amdgcn_global_load_lds((const unsigned*)((const char*)(gbase) + (voff)[_i]), (PG8_LAS unsigned*)(lds + (bufoff) + ldsw + _i * 8192), 16, 0, 0); } while (0)
#define PG8_LDA(dst, b, h) do { _Pragma("unroll") for (int m = 0; m < 4; ++m) _Pragma("unroll") for (int k = 0; k < 2; ++k) dst[m][k] = *(const PG8_LAS bf16x8*)(lds + PG8_SA(b, h) + aoff + m * 2048 + k * 1024); } while (0)
#define PG8_LDB(dst, b, h) do { _Pragma("unroll") for (int n = 0; n < 2; ++n) _Pragma("unroll") for (int k = 0; k < 2; ++k) dst[n][k] = *(const PG8_LAS bf16x8*)(lds + PG8_SB(b, h) + boff + n * 2048 + k * 1024); } while (0)
#define PG8_MMA(ai, bj, At, Bt) do { __builtin_amdgcn_s_setprio(1); _Pragma("unroll") for (int m = 0; m < 4; ++m) _Pragma("unroll") for (int n = 0; n < 2; ++n) _Pragma("unroll") for (int k = 0; k < 2; ++k) \
        acc[ai][bj][m][n] = __builtin_amdgcn_mfma_f32_16x16x32_bf16(Bt[n][k], At[m][k], acc[ai][bj][m][n], 0, 0, 0); __builtin_amdgcn_s_setprio(0); } while (0)
#define PG8_WAIT_V(n) asm volatile("s_waitcnt vmcnt(" #n ")" ::: "memory")
#define PG8_WAIT_L(n) asm volatile("s_waitcnt lgkmcnt(" #n ")" ::: "memory")
#define PG8_BAR __builtin_amdgcn_s_barrier()
#define PG8_SCHED __builtin_amdgcn_sched_barrier(0)
    Unit cur, nxt; int ui = 0;
    if (!S.next(0, cur)) return;
    f32x4 acc[2][2][4][2];
#pragma unroll
    for (int a = 0; a < 2; ++a)
#pragma unroll
        for (int b = 0; b < 2; ++b)
#pragma unroll
            for (int m = 0; m < 4; ++m)
#pragma unroll
                for (int n = 0; n < 2; ++n) acc[a][b][m][n] = (f32x4){0.f, 0.f, 0.f, 0.f};
    bf16x8 At[4][2], B0[2][2], B1[2][2];
    const char* cA = (const char*)g.A + (size_t)cur.pm * tstep; const char* cB = (const char*)g.Bt + (size_t)cur.pn * tstep;
    S.a_ready(cur);
    PG8_STAGE(PG8_SB(0, 0), cB, voffB); PG8_STAGE(PG8_SA(0, 0), cA, voffA); PG8_STAGE(PG8_SB(0, 1), cB + hstep, voffB); PG8_STAGE(PG8_SA(0, 1), cA + hstep, voffA);
    if (wr == 1) PG8_BAR;
    PG8_WAIT_V(4); PG8_BAR;
    PG8_STAGE(PG8_SB(1, 0), cB + kstep, voffB); PG8_STAGE(PG8_SA(1, 0), cA + kstep, voffA); PG8_STAGE(PG8_SB(1, 1), cB + hstep + kstep, voffB);
    PG8_WAIT_V(6); PG8_BAR;
    for (;;) {
        const bool has_next = S.next(ui + 1, nxt);
        const char* nA = has_next ? (const char*)g.A + (size_t)nxt.pm * tstep : cA; const char* nB = has_next ? (const char*)g.Bt + (size_t)nxt.pn * tstep : cB;
        for (int t = 0; t < nt; t += 2) {
            const bool last = (t == nt - 2);
            const char* a1 = cA + (size_t)(t + 1) * kstep;
            const char* a2 = last ? nA : cA + (size_t)(t + 2) * kstep; const char* b2 = last ? nB : cB + (size_t)(t + 2) * kstep;
            const char* a3 = a2 + kstep; const char* b3 = b2 + kstep;
            if (last && has_next) S.a_ready(nxt);
            PG8_LDB(B0, 0, 0); PG8_SCHED; PG8_LDA(At, 0, 0); PG8_STAGE(PG8_SA(1, 1), a1 + hstep, voffA);
            PG8_WAIT_L(8); PG8_BAR; PG8_WAIT_L(0); PG8_MMA(0, 0, At, B0); PG8_BAR; PG8_SCHED;
            PG8_LDB(B1, 0, 1); PG8_STAGE(PG8_SB(0, 0), b2, voffB);
            PG8_BAR; PG8_WAIT_L(0); PG8_MMA(0, 1, At, B1); PG8_BAR;
            PG8_LDA(At, 0, 1); PG8_STAGE(PG8_SA(0, 0), a2, voffA);
            PG8_BAR; PG8_WAIT_L(0); PG8_MMA(1, 0, At, B0); PG8_BAR; PG8_SCHED;
            PG8_STAGE(PG8_SB(0, 1), b2 + hstep, voffB);
            PG8_WAIT_V(6); PG8_BAR; PG8_MMA(1, 1, At, B1); PG8_BAR;
            PG8_LDB(B0, 1, 0); PG8_SCHED; PG8_LDA(At, 1, 0); PG8_STAGE(PG8_SA(0, 1), a2 + hstep, voffA);
            PG8_WAIT_L(8); PG8_BAR; PG8_WAIT_L(0); PG8_MMA(0, 0, At, B0); PG8_BAR; PG8_SCHED;
            PG8_LDB(B1, 1, 1); PG8_STAGE(PG8_SB(1, 0), b3, voffB);
            PG8_BAR; PG8_WAIT_L(0); PG8_MMA(0, 1, At, B1); PG8_BAR;
            PG8_LDA(At, 1, 1); PG8_STAGE(PG8_SA(1, 0), a3, voffA);
            PG8_BAR; PG8_WAIT_L(0); PG8_MMA(1, 0, At, B0); PG8_BAR; PG8_SCHED;
            PG8_STAGE(PG8_SB(1, 1), b3 + hstep, voffB);
            PG8_WAIT_V(6); PG8_BAR; PG8_MMA(1, 1, At, B1); PG8_BAR;
        }
        if constexpr (!Epi::AFTER_DRAIN) { E(acc, cur, wr, wc, fr, fq); S.done(cur); }
        if (!has_next) break;
#pragma unroll
        for (int a = 0; a < 2; ++a)
#pragma unroll
            for (int b = 0; b < 2; ++b)
#pragma unroll
                for (int m = 0; m < 4; ++m)
#pragma unroll
                    for (int n = 0; n < 2; ++n) acc[a][b][m][n] = (f32x4){0.f, 0.f, 0.f, 0.f};
        cur = nxt; cA = nA; cB = nB; ++ui;
    }
    PG8_WAIT_V(0);
    if (wr == 0) PG8_BAR;
    PG8_BAR;
    if constexpr (Epi::AFTER_DRAIN) { E.fused(acc, cur, wr, wc, fr, fq, lds, wid, lane); S.done(cur); }
#undef PG8_SA
#undef PG8_SB
#undef PG8_STAGE
#undef PG8_LDA
#undef PG8_LDB
#undef PG8_MMA
#undef PG8_WAIT_V
#undef PG8_WAIT_L
#undef PG8_BAR
#undef PG8_SCHED
}
}

typedef unsigned short bf16_t;
typedef float f32x4 __attribute__((ext_vector_type(4)));
typedef float f32x8 __attribute__((ext_vector_type(8)));
typedef unsigned u32x4 __attribute__((ext_vector_type(4)));
typedef unsigned u32x2 __attribute__((ext_vector_type(2)));
#define LAS __attribute__((address_space(3)))
__device__ __forceinline__ unsigned cvtpk(float lo, float hi) { unsigned r; asm volatile("v_cvt_pk_bf16_f32 %0, %1, %2" : "=v"(r) : "v"(lo), "v"(hi)); return r; }
__device__ __forceinline__ float bf2f(bf16_t b) { return __uint_as_float(((unsigned)b) << 16); }
__device__ __forceinline__ void store4bf(bf16_t* p, f32x4 v) { u32x2 w = {cvtpk(v[0], v[1]), cvtpk(v[2], v[3])}; *(u32x2*)p = w; }
__device__ __forceinline__ void st16_wt(__amdgpu_buffer_rsrc_t r, unsigned byte_off, u32x4 v) { __builtin_amdgcn_raw_buffer_store_b128(v, r, byte_off, 0,   16); }
__device__ __forceinline__ int opaque_tid() { int t = threadIdx.x; asm volatile("" : "+v"(t)); return t; }
__device__ __forceinline__ float siluf(float v) { return v * __builtin_amdgcn_rcpf(1.f + __builtin_amdgcn_exp2f(v * -1.4426950408889634f)); }

struct Epi1 {
  static constexpr bool PERM = false, AFTER_DRAIN = false;
  bf16_t* ZQ; bf16_t* KV; float* out; const float* gq; const float* gk; const float* ropeC; const float* ropeS; LAS float* part;
  __device__ __forceinline__ void operator()(const f32x4 (&acc)[2][2][4][2], const pg8::Unit& u, int wr, int wc, int fr, int fq) const {
    const int pn = u.pn, pm = u.pm; const bool ctx = pm < 32;
    const int fbase = 64 * (wc >> 1) + 16 * (wc & 1) + 8 * (fq & 1) + 4 * (fq >> 1), tok0 = 64 * wr + fr;
    bf16_t* dst; int rs, hs; float* ob = nullptr; int nh = 0, h0 = 0; int kind = 0;
    const int lb = (pm - 32) >> 3, lt = ((pm - 32) & 7) * 256;
    if (pn < 4) { dst = ZQ + (size_t)pm * 256 * DZ + ZQA + pn * 256; rs = DZ; hs = 128; }
    else if (pn < 12 || pn == 20 || pn == 21) {
      size_t ec, el;
      if (pn < 8) { ec = KAC_E; el = KAL_E; nh = 8; h0 = 2 * (pn - 4); if (ctx) ob = out + OUT_AK; }
      else if (pn < 12) { ec = VAC_E; el = VAL_E; nh = 8; h0 = 2 * (pn - 8); if (ctx) ob = out + OUT_AV; }
      else if (pn == 20) { ec = KBC_E; el = KBL_E; nh = 2; h0 = 0; kind = 2; if (ctx) ob = out + OUT_BK; }
      else { ec = VBC_E; el = VBL_E; nh = 2; h0 = 0; if (ctx) ob = out + OUT_BV; }
      rs = 128;
      if (ctx) { dst = KV + ec + ((size_t)(pm * nh + h0) * 256) * 128; hs = 256 * 128; }
      else { dst = KV + el + ((size_t)(lb * nh + h0) * 2048 + lt) * 128; hs = 2048 * 128; }
    }
    else if (pn < 16) { dst = ZQ + (size_t)pm * 256 * DZ + ZGA + (pn - 12) * 256; rs = DZ; hs = 128; kind = 1; }
    else if (pn < 20) { dst = ZQ + (size_t)pm * 256 * DZ + ZQB + (pn - 16) * 256; rs = DZ; hs = 128; kind = 2; }
    else { dst = ZQ + (size_t)pm * 256 * DZ + ZGB + (pn - 22) * 256; rs = DZ; hs = 128; kind = 1; }
    const int fb = (kind == 2) ? fbase : 32 * wc + 8 * fq;
    dst += (size_t)tok0 * rs + fb;
    if (ob) ob += ((size_t)(pm * nh + h0) * 256 + tok0) * 128 + fb;
    if (kind == 0) {
#pragma unroll
      for (int ai = 0; ai < 2; ++ai)
#pragma unroll
        for (int m = 0; m < 4; ++m) { const int dt = 128 * ai + 16 * m;
#pragma unroll
          for (int bj = 0; bj < 2; ++bj) { const f32x4 v0 = acc[ai][bj][m][0], v1 = acc[ai][bj][m][1];
            u32x4 w = {cvtpk(v0[0], v0[1]), cvtpk(v0[2], v0[3]), cvtpk(v1[0], v1[1]), cvtpk(v1[2], v1[3])};
            *(u32x4*)(dst + (size_t)dt * rs + bj * hs) = w;
            if (ob) { float* op = ob + ((size_t)bj * 256 + dt) * 128; *(f32x4*)op = v0; *(f32x4*)(op + 4) = v1; } } }
    } else if (kind == 1) {
#pragma unroll
      for (int ai = 0; ai < 2; ++ai)
#pragma unroll
        for (int m = 0; m < 4; ++m) { const int dt = 128 * ai + 16 * m;
#pragma unroll
          for (int bj = 0; bj < 2; ++bj) { const f32x4 v0 = acc[ai][bj][m][0], v1 = acc[ai][bj][m][1];
            u32x4 w = {cvtpk(siluf(v0[0]), siluf(v0[1])), cvtpk(siluf(v0[2]), siluf(v0[3])), cvtpk(siluf(v1[0]), siluf(v1[1])), cvtpk(siluf(v1[2]), siluf(v1[3]))};
            *(u32x4*)(dst + (size_t)dt * rs + bj * hs) = w; } }
    } else {
      const float* g = (pn == 20) ? gk : gq;
      const f32x4 g0 = *(const f32x4*)(g + fbase), g1 = *(const f32x4*)(g + fbase + 32);
      const int i0 = 16 * (wc & 1) + 8 * (fq & 1) + 4 * (fq >> 1); const bool colhalf = (wc >> 1) != 0;
      f32x4 cs4[4], sn4[4];
#pragma unroll
      for (int k = 0; k < 4; ++k) { const int pos = ctx ? 0 : (colhalf ? (16 * k + fr) : (((pm - 32) & 7) * 4 + 2 * (k & 1) + wr));
        cs4[k] = *(const f32x4*)(ropeC + pos * 32 + i0); sn4[k] = *(const f32x4*)(ropeS + pos * 32 + i0); }
#pragma unroll
      for (int bj = 0; bj < 2; ++bj)
#pragma unroll
        for (int ai = 0; ai < 2; ++ai)
#pragma unroll
          for (int m = 0; m < 4; ++m) { const f32x4 a = acc[ai][bj][m][0], b = acc[ai][bj][m][1];
            float s = a[0] * a[0] + a[1] * a[1] + a[2] * a[2] + a[3] * a[3] + b[0] * b[0] + b[1] * b[1] + b[2] * b[2] + b[3] * b[3];
            s += __shfl_xor(s, 16); s += __shfl_xor(s, 32);
            if (fq == 0) part[((wr * 4 + wc) * 16 + (bj * 8 + ai * 4 + m)) * 16 + fr] = s; }
      asm volatile("s_waitcnt lgkmcnt(0)" ::: "memory"); __builtin_amdgcn_s_barrier(); asm volatile("" ::: "memory");
      const int fst = 64 * (wc >> 1) + 16 * (wc & 1) + 8 * (fq & 1) + 32 * (fq >> 1) - fbase;
#pragma unroll
      for (int ai = 0; ai < 2; ++ai)
#pragma unroll
        for (int m = 0; m < 4; ++m) { const int dt = 128 * ai + 16 * m;
          const f32x4 cs = colhalf ? cs4[m] : cs4[ai], sn = colhalf ? sn4[m] : sn4[ai];
#pragma unroll
          for (int bj = 0; bj < 2; ++bj) { const int idx = (bj * 8 + ai * 4 + m) * 16 + fr;
            const float t = part[(wr * 4 + 0) * 256 + idx] + part[(wr * 4 + 1) * 256 + idx] + part[(wr * 4 + 2) * 256 + idx] + part[(wr * 4 + 3) * 256 + idx];
            const float r = rsqrtf(t * (1.f / 128.f) + 1e-6f);
            const f32x4 x1 = acc[ai][bj][m][0] * r * g0, x2 = acc[ai][bj][m][1] * r * g1;
            const f32x4 o1 = x1 * cs - x2 * sn, o2 = x2 * cs + x1 * sn;
            { const unsigned a0 = cvtpk(o1[0], o1[1]), a1 = cvtpk(o1[2], o1[3]), b0 = cvtpk(o2[0], o2[1]), b1 = cvtpk(o2[2], o2[3]);
              auto r0 = __builtin_amdgcn_permlane32_swap(a0, b0, false, false); auto r1 = __builtin_amdgcn_permlane32_swap(a1, b1, false, false);
              u32x4 w = {r0[0], r1[0], r0[1], r1[1]}; *(u32x4*)(dst + (size_t)dt * rs + bj * hs + fst) = w; }
            if (ob) { float* op = ob + ((size_t)bj * 256 + dt) * 128; *(f32x4*)op = o1; *(f32x4*)(op + 32) = o2; } } }
    }
  }
};
struct Epi2 {
  static constexpr bool PERM = false, AFTER_DRAIN = false;
  const float* xp; const float* xs; const float* mod; bf16_t* Y;
  __device__ __forceinline__ void operator()(const f32x4 (&acc)[2][2][4][2], const pg8::Unit& u, int wr, int wc, int fr, int fq) const {
    const int row0 = u.pm * 256 + 64 * wr + fr, c0 = u.pn * 256 + wc * 32 + 8 * fq;
    const int v = row0 < NPR ? 8 : ((row0 - NPR) >> 11);
    const float* gt = mod + v * 6144 + 4096 + c0;
    const f32x4 ga0 = *(const f32x4*)gt, ga1 = *(const f32x4*)(gt + 4), gb0 = *(const f32x4*)(gt + 128), gb1 = *(const f32x4*)(gt + 132);
    constexpr int XB = 4;
#pragma unroll
    for (int g0 = 0; g0 < 8; g0 += XB) {
      f32x4 xv[XB][2][2];
#pragma unroll
      for (int g = 0; g < XB; ++g) { const int ai = (g0 + g) >> 2, m = (g0 + g) & 3, row = row0 + 128 * ai + 16 * m;
        const float* xr = (row < NPR ? xp + (size_t)row * DM : xs + (size_t)(row - NPR) * DM) + c0;
#pragma unroll
        for (int bj = 0; bj < 2; ++bj) { xv[g][bj][0] = *(const f32x4*)(xr + bj * 128); xv[g][bj][1] = *(const f32x4*)(xr + bj * 128 + 4); } }
#pragma unroll
      for (int g = 0; g < XB; ++g) { const int ai = (g0 + g) >> 2, m = (g0 + g) & 3, row = row0 + 128 * ai + 16 * m; bf16_t* orow = Y + (size_t)row * DM + c0;
#pragma unroll
        for (int bj = 0; bj < 2; ++bj) { const f32x4 y0 = xv[g][bj][0] + (bj ? gb0 : ga0) * acc[ai][bj][m][0], y1 = xv[g][bj][1] + (bj ? gb1 : ga1) * acc[ai][bj][m][1];
          u32x4 w = {cvtpk(y0[0], y0[1]), cvtpk(y0[2], y0[3]), cvtpk(y1[0], y1[1]), cvtpk(y1[2], y1[3])};
          *(u32x4*)(orow + bj * 128) = w; } }
    }
  }
};

#define XB_TMO      128
#define XB_XCNT(j)  (256  + 64 * (j))
#define XB_XSUB(j)  (1280 + 64 * (j))
#define XB_XGEN(j)  (2304 + 64 * (j))
#define XB_TOP      3328
#define XB_TOPGEN   3392
#define XCD_BAR_WORDS 3456
#define XB_SPIN_CAP (1u << 18)
__device__ __forceinline__ unsigned xb_ld(unsigned* p)              { return __hip_atomic_load(p, __ATOMIC_RELAXED, __HIP_MEMORY_SCOPE_AGENT); }
__device__ __forceinline__ unsigned xb_add(unsigned* p, unsigned v) { return __hip_atomic_fetch_add(p, v, __ATOMIC_RELAXED, __HIP_MEMORY_SCOPE_AGENT); }
__device__ __forceinline__ unsigned xb_xcc_id() { return (unsigned)__builtin_amdgcn_s_getreg((3 << 11) | 20) & 0xFu; }
#define XB_SPIN(cond, bar) do { unsigned _sp = 0; while (cond) { __builtin_amdgcn_s_sleep(1); \
    if ((++_sp & 255u) == 0u) { if (xb_ld(&(bar)[XB_TMO])) break; if (_sp > XB_SPIN_CAP) { atomicAdd(&(bar)[XB_TMO], 1u); break; } } } } while (0)
struct XcdBarrier { unsigned* bar; unsigned x; volatile LAS unsigned* st; };
__device__ __forceinline__ XcdBarrier xcd_barrier_post(unsigned* bar, volatile LAS unsigned* st) {
    XcdBarrier b; b.bar = bar; b.x = xb_xcc_id(); b.st = st;
    if (threadIdx.x == 0) (void)xb_add(&bar[XB_XCNT(b.x)], 1u);
    return b;
}
__device__ __forceinline__ void xcd_barrier_complete(unsigned* bar, unsigned x, unsigned& nloc, unsigned& nx) {
    const unsigned G = gridDim.x * gridDim.y * gridDim.z;
    unsigned sum, cnt, mine, sp = 0u;
    for (;;) {
        sum = 0u; cnt = 0u; mine = 0u;
#pragma unroll
        for (unsigned j = 0; j < 16; ++j) { const unsigned c = xb_ld(&bar[XB_XCNT(j)]); sum += c; cnt += (c > 0u) ? 1u : 0u; mine = (j == x) ? c : mine; }
        if (sum == G) break;
        __builtin_amdgcn_s_sleep(1);
        if ((++sp & 255u) == 0u) { if (xb_ld(&bar[XB_TMO])) break; if (sp > XB_SPIN_CAP) { atomicAdd(&bar[XB_TMO], 1u); break; } }
    }
    nloc = mine > 0u ? mine : 1u; nx = cnt > 0u ? cnt : 1u;
}
__device__ __forceinline__ void xcd_barrier(const XcdBarrier& b) {
    asm volatile("s_waitcnt vmcnt(0)" ::: "memory");
    __syncthreads();
    if (threadIdx.x == 0) {
        unsigned* bar = b.bar;
        __builtin_amdgcn_s_waitcnt(0);
        unsigned nloc = b.st[0], nx = b.st[1];
        if (nloc == 0u) { xcd_barrier_complete(bar, b.x, nloc, nx); b.st[0] = nloc; b.st[1] = nx; }
        const unsigned old = xb_add(&bar[XB_XSUB(b.x)], 1u);
        const unsigned gen = old / nloc;
        if (old + 1u == (gen + 1u) * nloc) {
            __builtin_amdgcn_fence(__ATOMIC_RELEASE, "agent");
            asm volatile("s_waitcnt vmcnt(0)" ::: "memory");
            const unsigned og = xb_add(&bar[XB_TOP], 1u);
            const unsigned tg = og / nx;
            if (og + 1u == (tg + 1u) * nx) xb_add(&bar[XB_TOPGEN], 1u);
            else XB_SPIN(xb_ld(&bar[XB_TOPGEN]) == tg, bar);
            __builtin_amdgcn_fence(__ATOMIC_ACQUIRE, "agent");
            xb_add(&bar[XB_XGEN(b.x)], 1u);
            asm volatile("s_waitcnt vmcnt(0)" ::: "memory");
        } else {
            XB_SPIN(xb_ld(&bar[XB_XGEN(b.x)]) == gen, bar);
            __builtin_amdgcn_fence(__ATOMIC_ACQUIRE, "agent");
            asm volatile("s_waitcnt vmcnt(0)" ::: "memory");
        }
    }
    __syncthreads();
}

namespace att {
using bf16x8 = __attribute__((ext_vector_type(8))) short;
using s16x4  = __attribute__((ext_vector_type(4))) short;
using f32x16 = __attribute__((ext_vector_type(16))) float;
constexpr int D = 128, NW = 8, QBLK = 32, KVBLK = 64;
constexpr float SCALE = 0.088388347648318440f;
constexpr float THR = 8.f;
constexpr size_t SHM_V = KVBLK * D * 2, SHM_K = KVBLK * D * 2;
constexpr size_t OFF_WS = 2 * SHM_V + 2 * SHM_K, OFF_BIAS = OFF_WS + NW * 64 * 4;
constexpr size_t OFF_TEDGE = OFF_BIAS + 15 * 128 * 4, OFF_RPB = OFF_TEDGE + 15 * 15 * 64 * 4;
#define KSWZ(row, colB) ((row) * 256 + ((colB) ^ (((row) & 7) << 4)))
#define SBAR() __builtin_amdgcn_sched_barrier(0)
__device__ __forceinline__ int crow(int r, int hi) { return (r & 3) + 8 * (r >> 2) + 4 * hi; }
__device__ __forceinline__ void partialSM(f32x16& p0, f32x16& p1, float& m_reg, float& mn, float& alpha) {
  constexpr float C = SCALE * 1.4426950408889634f;
  float pmax = p0[0]; for (int r = 1; r < 16; ++r) pmax = fmaxf(pmax, p0[r]); for (int r = 0; r < 16; ++r) pmax = fmaxf(pmax, p1[r]);
  { auto rr = __builtin_amdgcn_permlane32_swap(__float_as_uint(pmax), __float_as_uint(pmax), false, false);
    pmax = fmaxf(__uint_as_float(rr[0]), __uint_as_float(rr[1])); }
  if (__builtin_expect(__all(pmax - m_reg <= THR / SCALE), 1)) { mn = m_reg; alpha = 1.f; }
  else { mn = fmaxf(m_reg, pmax); alpha = __builtin_amdgcn_exp2f((m_reg - mn) * C); m_reg = mn; }
  float mnC = -mn * C;
  for (int r = 0; r < 16; ++r) p0[r] = fmaf(p0[r], C, mnC); for (int r = 0; r < 16; ++r) p1[r] = fmaf(p1[r], C, mnC);
  for (int r = 0; r < 16; ++r) p0[r] = __builtin_amdgcn_exp2f(p0[r]);
}
__device__ __forceinline__ void finishSM(f32x16& p0, f32x16& p1, float alpha, float& l_reg, bf16x8& pa0, bf16x8& pa1, bf16x8& pa2, bf16x8& pa3) {
  for (int r = 0; r < 16; ++r) p1[r] = __builtin_amdgcn_exp2f(p1[r]);
  float ps = 0; for (int r = 0; r < 16; ++r) ps += p0[r]; for (int r = 0; r < 16; ++r) ps += p1[r];
  { auto rr = __builtin_amdgcn_permlane32_swap(__float_as_uint(ps), __float_as_uint(ps), false, false);
    ps = __uint_as_float(rr[0]) + __uint_as_float(rr[1]); }
  l_reg = l_reg * alpha + ps;
#define PK4(P, BASE, OUT) do { unsigned a0 = cvtpk(P[BASE + 0], P[BASE + 1]), a1 = cvtpk(P[BASE + 2], P[BASE + 3]);   \
    unsigned b0 = cvtpk(P[BASE + 4], P[BASE + 5]), b1 = cvtpk(P[BASE + 6], P[BASE + 7]);                              \
    auto r0 = __builtin_amdgcn_permlane32_swap(a0, b0, false, false); auto r1 = __builtin_amdgcn_permlane32_swap(a1, b1, false, false); \
    u32x4 w = {r0[0], r1[0], r0[1], r1[1]}; OUT = *reinterpret_cast<bf16x8*>(&w); } while (0)
  PK4(p0, 0, pa0); PK4(p0, 8, pa1); PK4(p1, 0, pa2); PK4(p1, 8, pa3);
#undef PK4
}
__device__ __forceinline__ void qkt(f32x16& p0, f32x16& p1, const char* Ks, const bf16x8* qr, int r32, int hi) {
  p0 = f32x16{}; p1 = f32x16{};
  for (int d0 = 0; d0 < 8; ++d0) { int cb = (d0 * 16 + hi * 8) * 2;
    bf16x8 b0 = *reinterpret_cast<const bf16x8*>(Ks + KSWZ(r32, cb));
    bf16x8 b1 = *reinterpret_cast<const bf16x8*>(Ks + KSWZ(32 + r32, cb));
    p0 = __builtin_amdgcn_mfma_f32_32x32x16_bf16(b0, qr[d0], p0, 0, 0, 0);
    p1 = __builtin_amdgcn_mfma_f32_32x32x16_bf16(b1, qr[d0], p1, 0, 0, 0); }
}
__device__ __forceinline__ int v_st(int k, int c) { const int kk = (k & ~0xC) | ((k & 4) << 1) | ((k & 8) >> 1); return ((kk >> 3) * 4 + (c >> 5)) * 512 + ((kk & 7) * 32 + (c & 31)) * 2; }
__device__ __forceinline__ int v_rd_base(int lane) { return ((lane & 3) << 3) | (((lane >> 2) & 3) << 6) | (((lane >> 4) & 1) << 5) | (((lane >> 5) & 1) << 8); }
constexpr int v_rd_off(int d0, int ks, int half) { return d0 * 512 + ks * 4096 + half * 2048; }
template <int OFF> __device__ __forceinline__ s16x4 tr_read(int vb) {
  s16x4 r; asm volatile("ds_read_b64_tr_b16 %0, %1 offset:%2" : "=&v"(r) : "v"(vb), "i"(OFF) : "memory"); return r;
}
template <int D0> __device__ __forceinline__ void pv_one(f32x16& od, int vb, bf16x8 pa0, bf16x8 pa1, bf16x8 pa2, bf16x8 pa3) {
  const s16x4 l0 = tr_read<v_rd_off(D0, 0, 0)>(vb), h0 = tr_read<v_rd_off(D0, 0, 1)>(vb), l1 = tr_read<v_rd_off(D0, 1, 0)>(vb), h1 = tr_read<v_rd_off(D0, 1, 1)>(vb);
  const s16x4 l2 = tr_read<v_rd_off(D0, 2, 0)>(vb), h2 = tr_read<v_rd_off(D0, 2, 1)>(vb), l3 = tr_read<v_rd_off(D0, 3, 0)>(vb), h3 = tr_read<v_rd_off(D0, 3, 1)>(vb);
  asm volatile("s_waitcnt lgkmcnt(0)" ::: "memory"); SBAR();
#define PK(L, H) (bf16x8){L[0], L[1], L[2], L[3], H[0], H[1], H[2], H[3]}
  od = __builtin_amdgcn_mfma_f32_32x32x16_bf16(pa0, PK(l0, h0), od, 0, 0, 0);
  od = __builtin_amdgcn_mfma_f32_32x32x16_bf16(pa1, PK(l1, h1), od, 0, 0, 0);
  od = __builtin_amdgcn_mfma_f32_32x32x16_bf16(pa2, PK(l2, h2), od, 0, 0, 0);
  od = __builtin_amdgcn_mfma_f32_32x32x16_bf16(pa3, PK(l3, h3), od, 0, 0, 0);
#undef PK
}
__device__ __forceinline__ void pv_d0(f32x16* o, int vb, bf16x8 pa0, bf16x8 pa1, bf16x8 pa2, bf16x8 pa3) {
  pv_one<0>(o[0], vb, pa0, pa1, pa2, pa3); pv_one<1>(o[1], vb, pa0, pa1, pa2, pa3); pv_one<2>(o[2], vb, pa0, pa1, pa2, pa3); pv_one<3>(o[3], vb, pa0, pa1, pa2, pa3);
}
__device__ __forceinline__ void nb_hook(f32x16& p0, f32x16& p1, const float* bt) {
#pragma unroll
  for (int r = 0; r < 16; ++r) { const int kc = (r & 3) + 8 * (r >> 2); p0[r] += bt[kc]; p1[r] += bt[kc + 32]; if ((r & 3) == 3) SBAR(); }
}

template <int MODE>
__device__ __forceinline__ void attn_item(const bf16_t* __restrict__ Qb, const bf16_t* __restrict__ K0, const bf16_t* __restrict__ V0, int T0,
                                          const bf16_t* __restrict__ K1, const bf16_t* __restrict__ V1, int NT,
                                          const bf16_t* __restrict__ Gb, bf16_t* __restrict__ Ob, int kr0, int rw0, char* lds) {
  const int tid = opaque_tid(), wid = __builtin_amdgcn_readfirstlane(tid >> 6), lane = tid & 63, r32 = lane & 31, hi = lane >> 5;
  char* V_lds = lds; char* K_lds = lds + 2 * SHM_V;
  float* ws = (float*)(lds + OFF_WS) + wid * 64; float* li_l = ws; float* al_l = ws + 32;
  const int rw = rw0 + (wid >> 1), qc = (wid & 1) * 32 + r32, rs = min(max(rw - 4, 0), 24);
  const bool edge = qc < 8 || qc > 56;
  const float* bias0 = edge ? (const float*)(lds + OFF_TEDGE) + (qc < 8 ? qc : qc - 49) * 64 + 4 * hi : (const float*)(lds + OFF_BIAS) + (4 * hi - qc + 63);
  const int bstr = edge ? 960 : 128;
  float m_reg = -1e30f, l_reg = 0; f32x16 o[4] = {}; bf16x8 qr[8];
  const bf16_t* Qw = Qb + (long)(wid * QBLK + r32) * DZ + hi * 8;
#pragma unroll
  for (int d0 = 0; d0 < 8; ++d0) qr[d0] = *reinterpret_cast<const bf16x8*>(Qw + d0 * 16);
  const int sr = tid >> 4, sc = (tid & 15) * 8, vst0 = v_st(sr, sc), vst1 = v_st(32 + sr, sc);
  const int vb0 = (int)(uintptr_t)V_lds + v_rd_base(lane); const int soff = sr * D + sc;
  constexpr int SD = (MODE == 1) ? 1 : 2;
  struct { bf16x8 vs0, vs1, ks0, ks1; } sr_[SD];
#define SLOAD(i, t) do { const int _t = (t); const bool _s1 = _t >= T0; const int _tt = _s1 ? _t - T0 : _t; \
    const bf16_t* _kb = (_s1 ? K1 : K0) + (long)_tt * (KVBLK * D); const bf16_t* _vb = (_s1 ? V1 : V0) + (long)_tt * (KVBLK * D); \
    sr_[i].vs0 = *reinterpret_cast<const bf16x8*>(_vb + soff); sr_[i].vs1 = *reinterpret_cast<const bf16x8*>(_vb + soff + 32 * D); \
    sr_[i].ks0 = *reinterpret_cast<const bf16x8*>(_kb + soff); sr_[i].ks1 = *reinterpret_cast<const bf16x8*>(_kb + soff + 32 * D); } while (0)
#define SWRITE(b, i) do { *(bf16x8*)(V_lds + (b) * SHM_V + vst0) = sr_[i].vs0;          \
    *(bf16x8*)(V_lds + (b) * SHM_V + vst1) = sr_[i].vs1; int kc = sc * 2;               \
    *(bf16x8*)(K_lds + (b) * SHM_K + KSWZ(sr, kc)) = sr_[i].ks0;                       \
    *(bf16x8*)(K_lds + (b) * SHM_K + KSWZ(32 + sr, kc)) = sr_[i].ks1; } while (0)
#define SWAIT() do { if (SD == 2) asm volatile("s_waitcnt vmcnt(4)" ::: "memory"); else asm volatile("s_waitcnt vmcnt(0)" ::: "memory"); } while (0)
#define RESC(a) do { if (__any((a) < 1.f)) { if (hi == 0) al_l[r32] = (a); asm volatile("s_waitcnt lgkmcnt(0)" ::: "memory"); \
    for (int d = 0; d < 4; ++d) for (int r = 0; r < 16; ++r) o[d][r] *= al_l[crow(r, hi)]; } } while (0)
  f32x16 pA0, pA1, pB0, pB1; float mnA, mnB, alA, alB; bf16x8 pa0, pa1, pa2, pa3;
  constexpr int SE = 0, SO = SD - 1;
#define TVAL(t) (MODE == 0 || (t) < T0 || (unsigned)(kr0 + (t) - T0 - rs) < 8u)
#define HALF(VC, VP, pC0, pC1, pP0, pP1, alC, mnC, alP, KOFF, VOFF, TC, DOLOAD, LSLOT, LTILE) do { \
    SBAR(); if (VC) qkt(pC0, pC1, K_lds + (KOFF), qr, r32, hi); \
    if (VP) finishSM(pP0, pP1, alP, l_reg, pa0, pa1, pa2, pa3); SBAR(); \
    if (DOLOAD) SLOAD(LSLOT, LTILE); SBAR(); \
    if (VP) pv_d0(o, vb0 + (int)(VOFF), pa0, pa1, pa2, pa3); \
    if (VC) { if (MODE == 1 && (TC) >= T0) nb_hook(pC0, pC1, bias0 + (kr0 + (TC) - T0 - rw + 7) * bstr); partialSM(pC0, pC1, m_reg, mnC, alC); } else alC = 1.f; } while (0)
#define HALF4(vc, vp, ...) HALF(vc, vp, __VA_ARGS__)
  SLOAD(SE, 0); if (SD == 2) { SLOAD(SO, 1); asm volatile("s_waitcnt vmcnt(4)" ::: "memory"); } else asm volatile("s_waitcnt vmcnt(0)" ::: "memory");
  SWRITE(0, SE); __syncthreads();
  qkt(pA0, pA1, K_lds, qr, r32, hi); partialSM(pA0, pA1, m_reg, mnA, alA);
  if (SD == 2) { if (2 < NT) SLOAD(SE, 2); } else SLOAD(SO, 1);
  SWAIT(); SWRITE(1, SO); __syncthreads();
  bool vA = true, vB;
  for (int j = 1; j + 1 < NT; j += 2) {
    vB = TVAL(j);
    HALF4(vB, vA, pB0, pB1, pA0, pA1, alB, mnB, alA, SHM_K, 0, j, true, SO, j + SD);
    __syncthreads(); SWAIT(); SWRITE(0, SE);
    RESC(alB); __syncthreads();
    vA = TVAL(j + 1);
    HALF4(vA, vB, pA0, pA1, pB0, pB1, alA, mnA, alB, 0, SHM_V, j + 1, (SD == 1 || j + 3 < NT), SE, j + 1 + SD);
    __syncthreads(); SWAIT(); SWRITE(1, SO);
    RESC(alA); __syncthreads();
  }
  vB = TVAL(NT - 1);
  HALF4(vB, vA, pB0, pB1, pA0, pA1, alB, mnB, alA, SHM_K, 0, NT - 1, false, SO, 0);
  __syncthreads(); RESC(alB);
  if (vB) { finishSM(pB0, pB1, alB, l_reg, pa0, pa1, pa2, pa3); SBAR();
    pv_d0(o, vb0 + (int)SHM_V, pa0, pa1, pa2, pa3); }
#undef HALF4
#undef HALF
#undef TVAL
  const bf16_t* Gw = Gb + (long)(wid * QBLK) * DZ; u32x4 gvv[8];
#pragma unroll
  for (int i = 0; i < 8; ++i) { const int c = lane + 64 * i; gvv[i] = *(const u32x4*)(Gw + (c >> 4) * DZ + (c & 15) * 8); }
  if (hi == 0) li_l[r32] = l_reg; asm volatile("s_waitcnt lgkmcnt(0)" ::: "memory");
  float rli[16];
#pragma unroll
  for (int r = 0; r < 16; ++r) rli[r] = __builtin_amdgcn_rcpf(li_l[crow(r, hi)]);
  __syncthreads();
  char* obase = lds + wid * 8192;
#pragma unroll
  for (int r = 0; r < 16; ++r) { const int orow = crow(r, hi);
#pragma unroll
    for (int d0 = 0; d0 < 4; ++d0) *(bf16_t*)(obase + orow * 256 + (d0 * 32 + r32) * 2) = (bf16_t)(cvtpk(o[d0][r] * rli[r], 0.f) & 0xffffu); }
  asm volatile("s_waitcnt lgkmcnt(0)" ::: "memory");
  bf16_t* Ow = Ob + (long)(wid * QBLK) * LDH;
#pragma unroll
  for (int i = 0; i < 8; ++i) { const int c = lane + 64 * i, row = c >> 4, cc = (c & 15) * 8;
    const u32x4 ov = *(const u32x4*)(obase + row * 256 + cc * 2); const u32x4 gv = gvv[i];
    u32x4 w;
#pragma unroll
    for (int q = 0; q < 4; ++q) { const float a0 = __uint_as_float(ov[q] << 16) * __uint_as_float(gv[q] << 16), a1 = __uint_as_float(ov[q] & 0xffff0000u) * __uint_as_float(gv[q] & 0xffff0000u); w[q] = cvtpk(a0, a1); }
    *(u32x4*)(Ow + row * LDH + cc) = w; }
#undef SLOAD
#undef SWRITE
#undef SWAIT
#undef RESC
}
}

__device__ __forceinline__ float wave_sum(float v) {
#pragma unroll
  for (int o = 32; o >= 1; o >>= 1) v += __shfl_xor(v, o);
  return v;
}
constexpr int P0_GEMV = 192, P0_WIN = 1664, P0_WOUT = 512, P0_CACHE = 320, P0_TOTAL = P0_GEMV + P0_WIN + P0_WOUT + P0_CACHE + 1;
__device__ __forceinline__ void p0_gemv(const Params& p, int ci, char* shm) {
  const int tid = opaque_tid(); float* sc = (float*)shm;
  for (int i = tid; i < 9 * 2048; i += 512) { const int v = i >> 11, k = i & 2047; const float cv = v < 8 ? p.c[v * 2048 + k] : p.c_ctx[k]; sc[i] = siluf(cv); }
  __syncthreads();
  const int c4 = tid & 7, kg = tid >> 3;
  f32x4 acc[9];
#pragma unroll
  for (int v = 0; v < 9; ++v) acc[v] = (f32x4){0.f, 0.f, 0.f, 0.f};
  const float* wp = p.w_ada + (size_t)kg * 6144 + ci * 32 + c4 * 4;
#pragma unroll 8
  for (int i = 0; i < 32; ++i) { const f32x4 w = *(const f32x4*)(wp + (size_t)i * 64 * 6144); const int k = kg + 64 * i;
#pragma unroll
    for (int v = 0; v < 9; ++v) acc[v] += w * sc[v * 2048 + k]; }
  __syncthreads();
  float* red = (float*)shm;
#pragma unroll
  for (int v = 0; v < 9; ++v) *(f32x4*)(red + (kg * 9 + v) * 32 + c4 * 4) = acc[v];
  __syncthreads();
  if (tid < 288) { const int v = tid >> 5, cc = tid & 31; float s = 0.f; for (int g = 0; g < 64; ++g) s += red[(g * 9 + v) * 32 + cc];
    const int col = ci * 32 + cc; ((float*)(p.ws + WS_MOD))[v * 6144 + col] = s + p.b_ada[col]; }
  __syncthreads();
}
struct TrItem { const float* src; int ncols; bf16_t* dst; int hb, kc, perm; };
__device__ __forceinline__ TrItem tr_item(const Params& p, int it) {
  TrItem t;
  if (it < P0_GEMV + P0_WIN) { const int i = it - P0_GEMV; t.src = p.w_in; t.ncols = DIN; t.dst = (bf16_t*)(p.ws + WS_WTIN); t.hb = i >> 5; t.kc = i & 31; t.perm = (t.hb >= 32 && t.hb < 42) ? 1 : 2; }
  else { const int i = it - P0_GEMV - P0_WIN; t.src = p.w_out; t.ncols = DM; t.dst = (bf16_t*)(p.ws + WS_WTOUT); t.hb = i >> 5; t.kc = i & 31; t.perm = 2; }
  return t;
}
__device__ __forceinline__ void tr_load(const TrItem& t, int tid, f32x4 (&w)[4]) {
#pragma unroll
  for (int i = 0; i < 4; ++i) { const int idx = tid + 512 * i, kk = idx >> 5, c4 = idx & 31; w[i] = *(const f32x4*)(t.src + (size_t)(t.kc * 64 + kk) * t.ncols + t.hb * 128 + c4 * 4); }
}
__device__ __forceinline__ void tr_put(int tid, const f32x4 (&w)[4], float* tl) {
#pragma unroll
  for (int i = 0; i < 4; ++i) { const int idx = tid + 512 * i, kk = idx >> 5, c4 = idx & 31; float* q = tl + kk * 129 + c4 * 4; q[0] = w[i][0]; q[1] = w[i][1]; q[2] = w[i][2]; q[3] = w[i][3]; }
}
__device__ __forceinline__ void tr_out(const TrItem& t, int tid, const float* tl) {
#pragma unroll
  for (int i = 0; i < 2; ++i) { const int task = tid + 512 * i, o = task & 7, s = task >> 3;
    const int f = t.perm == 1 ? ((s & 0x43) | ((s & 0x10) << 1) | ((s & 0x20) >> 1) | ((s & 0x04) << 1) | ((s & 0x08) >> 1)) : t.perm == 2 ? ((s & 0x63) | ((s & 0x0C) << 1) | ((s & 0x10) >> 2)) : s;
    const float* q = tl + (8 * o) * 129 + f;
    u32x4 w = {cvtpk(q[0], q[129]), cvtpk(q[2 * 129], q[3 * 129]), cvtpk(q[4 * 129], q[5 * 129]), cvtpk(q[6 * 129], q[7 * 129])};
    *(u32x4*)(t.dst + (size_t)(t.hb * 128 + s) * LDH + t.kc * 64 + 8 * o) = w; }
}
__device__ __forceinline__ void p0_transpose2(const Params& p, int it0, int it1, char* shm) {
  const int tid = opaque_tid(); float* tl0 = (float*)shm; float* tl1 = tl0 + 64 * 129;
  const TrItem a = tr_item(p, it0); f32x4 wa[4], wb[4]; tr_load(a, tid, wa);
  if (it1 >= 0) { const TrItem b = tr_item(p, it1); tr_load(b, tid, wb); tr_put(tid, wa, tl0); tr_put(tid, wb, tl1); __syncthreads(); tr_out(a, tid, tl0); tr_out(b, tid, tl1); }
  else { tr_put(tid, wa, tl0); __syncthreads(); tr_out(a, tid, tl0); }
  __syncthreads();
}
__device__ __forceinline__ void p0_cache(const Params& p, int item) {
  bf16_t* dst = (bf16_t*)(p.ws + WS_CACHE); const int tid = opaque_tid();
#pragma unroll
  for (int i = 0; i < 8; ++i) { const size_t g = (size_t)item * 4096 + tid + 512 * i;
    const float* src; size_t gl;
    if (g < CAV_E / 8) { src = p.cak; gl = g; } else if (g < CBK_E / 8) { src = p.cav; gl = g - CAV_E / 8; } else if (g < CBV_E / 8) { src = p.cbk; gl = g - CBK_E / 8; } else { src = p.cbv; gl = g - CBV_E / 8; }
    const f32x8 x = *(const f32x8*)(src + gl * 8);
    u32x4 w = {cvtpk(x[0], x[1]), cvtpk(x[2], x[3]), cvtpk(x[4], x[5]), cvtpk(x[6], x[7])};
    *(u32x4*)(dst + g * 8) = w; }
}
__device__ __forceinline__ void p0_rope(const Params& p) {
  float* rc = (float*)(p.ws + WS_ROPE); float* rs = rc + 64 * 32; const int tid = opaque_tid();
#pragma unroll 1
  for (int q = 0; q < 4; ++q) { const int e = tid * 4 + q, pos = e >> 5, i = e & 31;
    double f = 1.0; for (int j = 0; j < i; ++j) f *= 0.7498942093324559;
    const double ang = (double)pos * f; const double kk = __builtin_rint(ang * 0.15915494309189535); const double r = ang - kk * 6.283185307179586, r2 = r * r;
    double s = r, c = 1.0, ts = r, tc = 1.0;
#pragma unroll 1
    for (int n = 1; n <= 15; ++n) { tc *= -r2 / (double)((2 * n - 1) * (2 * n)); c += tc; ts *= -r2 / (double)((2 * n) * (2 * n + 1)); s += ts; }
    rc[e] = (float)c; rs[e] = (float)s; }
}
__device__ __forceinline__ void phase0(const Params& p, char* shm) {
  const int G = (int)gridDim.x, c = (int)blockIdx.x;
  if (G >= 256) {
    if (c < P0_GEMV) p0_gemv(p, c, shm);
    constexpr int NPAIR = P0_WIN / 2, NA = 480;
    if (c < P0_GEMV) { for (int q = c; q < NA; q += P0_GEMV) p0_transpose2(p, P0_GEMV + 2 * q, P0_GEMV + 2 * q + 1, shm); }
    else { for (int q = NA + (c - P0_GEMV); q < NPAIR; q += G - P0_GEMV) p0_transpose2(p, P0_GEMV + 2 * q, P0_GEMV + 2 * q + 1, shm); }
    if (c == G - 1) p0_rope(p);
  } else {
    for (int it = c; it < P0_GEMV; it += G) p0_gemv(p, it, shm);
    for (int q = c; q < P0_WIN / 2; q += G) p0_transpose2(p, P0_GEMV + 2 * q, P0_GEMV + 2 * q + 1, shm);
    if (c == G - 1) p0_rope(p);
  }
}
__device__ __forceinline__ void phase0_late(const Params& p, char* shm, int first, int count) {
  const int r = (int)blockIdx.x - first; if (r < 0 || r >= count) return;
  for (int q = r; q < P0_WOUT / 2; q += count) p0_transpose2(p, P0_GEMV + P0_WIN + 2 * q, P0_GEMV + P0_WIN + 2 * q + 1, shm);
  for (int it = r; it < P0_CACHE; it += count) p0_cache(p, it);
}
__device__ __forceinline__ void phase1(const Params& p) {
  const int tid = opaque_tid(), wid = tid >> 6, lane = tid & 63; const float* mod = (const float*)(p.ws + WS_MOD); bf16_t* H = (bf16_t*)(p.ws + WS_H);
  const int nw = (int)gridDim.x * 8, per = (NTOK + nw - 1) / nw, w = blockIdx.x * 8 + wid;
  f32x4 A[4][2], B[4][2]; int vcur = -1;
  const __amdgpu_buffer_rsrc_t rH = __builtin_amdgcn_make_buffer_rsrc((void*)(p.ws + WS_H), (short)0, (int)((size_t)NTOK * LDH * 2), 0x00020000);
  for (int row = w * per; row < min((w + 1) * per, NTOK); ++row) {
    const float* xr = row < NPR ? p.x_prompt + (size_t)row * DM : p.x_sample + (size_t)(row - NPR) * DM;
    const int v = row < NPR ? 8 : ((row - NPR) >> 11);
    f32x4 x[4][2]; float ss = 0.f;
#pragma unroll
    for (int i = 0; i < 4; ++i)
#pragma unroll
      for (int h = 0; h < 2; ++h) { x[i][h] = *(const f32x4*)(xr + (lane + 64 * i) * 8 + 4 * h); ss += x[i][h][0] * x[i][h][0] + x[i][h][1] * x[i][h][1] + x[i][h][2] * x[i][h][2] + x[i][h][3] * x[i][h][3]; }
    if (v != vcur) { vcur = v;
#pragma unroll
      for (int i = 0; i < 4; ++i)
#pragma unroll
        for (int h = 0; h < 2; ++h) { const int c = (lane + 64 * i) * 8 + 4 * h;
          A[i][h] = *(const f32x4*)(p.g_norm + c) * (*(const f32x4*)(mod + v * 6144 + 2048 + c) + 1.f); B[i][h] = *(const f32x4*)(mod + v * 6144 + c); } }
    ss = wave_sum(ss); const float rstd = rsqrtf(ss * (1.f / DM) + 1e-6f);
#pragma unroll
    for (int i = 0; i < 4; ++i) { const f32x4 h0 = (x[i][0] * rstd) * A[i][0] + B[i][0], h1 = (x[i][1] * rstd) * A[i][1] + B[i][1];
      u32x4 wv = {cvtpk(h0[0], h0[1]), cvtpk(h0[2], h0[3]), cvtpk(h1[0], h1[1]), cvtpk(h1[2], h1[3])};
      st16_wt(rH, (unsigned)(((size_t)row * LDH + (lane + 64 * i) * 8) * 2), wv); }
  }
}
__device__ __forceinline__ void phase5(const Params& p) {
  const int tid = opaque_tid(), wid = tid >> 6, lane = tid & 63; const bf16_t* Y = (const bf16_t*)(p.ws + WS_ZQ);
  f32x4 G[4][2];
#pragma unroll
  for (int i = 0; i < 4; ++i)
#pragma unroll
    for (int h = 0; h < 2; ++h) G[i][h] = *(const f32x4*)(p.g_final + (lane + 64 * i) * 8 + 4 * h);
  for (int row = blockIdx.x * 8 + wid; row < NTOK; row += gridDim.x * 8) {
    const bf16_t* yr = Y + (size_t)row * DM; float* orow = p.out + (size_t)row * DM;
    f32x4 x[4][2]; float ss = 0.f;
#pragma unroll
    for (int i = 0; i < 4; ++i) { const u32x4 w = *(const u32x4*)(yr + (lane + 64 * i) * 8);
      x[i][0][0] = __uint_as_float(w[0] << 16); x[i][0][1] = __uint_as_float(w[0] & 0xffff0000u); x[i][0][2] = __uint_as_float(w[1] << 16); x[i][0][3] = __uint_as_float(w[1] & 0xffff0000u);
      x[i][1][0] = __uint_as_float(w[2] << 16); x[i][1][1] = __uint_as_float(w[2] & 0xffff0000u); x[i][1][2] = __uint_as_float(w[3] << 16); x[i][1][3] = __uint_as_float(w[3] & 0xffff0000u);
#pragma unroll
      for (int h = 0; h < 2; ++h) ss += x[i][h][0] * x[i][h][0] + x[i][h][1] * x[i][h][1] + x[i][h][2] * x[i][h][2] + x[i][h][3] * x[i][h][3]; }
    ss = wave_sum(ss); const float rstd = rsqrtf(ss * (1.f / DM) + 1e-6f);
#pragma unroll
    for (int i = 0; i < 4; ++i)
#pragma unroll
      for (int h = 0; h < 2; ++h) *(f32x4*)(orow + (lane + 64 * i) * 8 + 4 * h) = x[i][h] * rstd * G[i][h];
  }
}
__device__ __forceinline__ void phase3(const Params& p, char* shm) {
  const bf16_t* ZQ = (const bf16_t*)(p.ws + WS_ZQ); const bf16_t* KV = (const bf16_t*)(p.ws + WS_KV); bf16_t* G = (bf16_t*)(p.ws + WS_H); const bf16_t* CB = (const bf16_t*)(p.ws + WS_CACHE);
  int tab_h = -1;
  unsigned* ctr = (unsigned*)(p.ws + WS_CTR); volatile LAS int* slot = (volatile LAS int*)((LAS unsigned char*)shm + (LDS_BYTES - 64));
  int it = blockIdx.x; bool dyn = false;
  for (;;) {
    __syncthreads();
    if (!dyn && it >= 1024) dyn = true;
    if (dyn) { if (threadIdx.x == 0) *slot = (int)__hip_atomic_fetch_add(ctr, 1u, __ATOMIC_RELAXED, __HIP_MEMORY_SCOPE_AGENT); __syncthreads(); it = 1024 + *slot; if (it >= 1536) break; }
    const bf16_t *Q, *K0, *V0, *K1, *V1, *Gt; bf16_t* O; int T0, NT, kr0 = 0, rw0 = 0;
    if (it < 512) { const int b = it >> 6, hq = (it >> 3) & 7, qb = it & 7, kvh = hq >> 2; const size_t rq = (size_t)NPR + b * 2048 + qb * 256;
      Q = ZQ + rq * DZ + ZQB + hq * 128; Gt = ZQ + rq * DZ + ZGB + hq * 128; O = G + rq * LDH + 1024 + hq * 128;
      K0 = KV + KBL_E + (size_t)(b * 2 + kvh) * 2048 * 128; V0 = KV + VBL_E + (size_t)(b * 2 + kvh) * 2048 * 128; T0 = 32;
      K1 = CB + CBK_E + (size_t)(b * 2 + kvh) * 512 * 128; V1 = CB + CBV_E + (size_t)(b * 2 + kvh) * 512 * 128; NT = 40;
    } else if (it < 1024) { const int i = it - 512, b = i >> 6, h = (i >> 3) & 7, rg = i & 7; const size_t rq = (size_t)NPR + b * 2048 + rg * 256;
      const int lo = min(max(4 * rg - 4, 0), 24), nb = (rg == 0 || rg == 7) ? 8 : 12;
      Q = ZQ + rq * DZ + ZQA + h * 128; Gt = ZQ + rq * DZ + ZGA + h * 128; O = G + rq * LDH + h * 128;
      K0 = CB + CAK_E + (size_t)(b * 8 + h) * 512 * 128; V0 = CB + CAV_E + (size_t)(b * 8 + h) * 512 * 128; T0 = 8;
      K1 = KV + KAL_E + ((size_t)(b * 8 + h) * 2048 + lo * 64) * 128; V1 = KV + VAL_E + ((size_t)(b * 8 + h) * 2048 + lo * 64) * 128; NT = 8 + nb; kr0 = lo; rw0 = 4 * rg;
      if (h != tab_h) { tab_h = h; const int tb = opaque_tid(); float* rp = (float*)(shm + att::OFF_RPB); float* ti = (float*)(shm + att::OFF_BIAS); float* te = (float*)(shm + att::OFF_TEDGE);
        if (tb < 465) rp[tb] = p.rpb[h * 465 + tb] * (1.f / att::SCALE);
        __syncthreads();
        for (int i = tb; i < 15 * 128; i += 512) { const int ro = i >> 7, dd = (i & 127) - 48; ti[i] = (dd >= 7 && dd <= 22) ? rp[ro * 31 + dd] : -1e30f; }
        for (int i = tb; i < 15 * 960; i += 512) { const int ro = i / 960, rem = i - ro * 960, eq = rem >> 6, kc = rem & 63, qcol = eq < 8 ? eq : eq + 49;
          const int cst = min(max(qcol - 8, 0), 48), dd = kc - qcol + 15; te[i] = ((unsigned)(kc - cst) < 16u) ? rp[ro * 31 + dd] : -1e30f; } }
    } else if (it < 1280) { const int i = it - 1024, b = i >> 3, h = i & 7; const size_t r0 = (size_t)b * 256;
      Q = ZQ + r0 * DZ + ZQA + h * 128; Gt = ZQ + r0 * DZ + ZGA + h * 128; O = G + r0 * LDH + h * 128;
      K0 = KV + KAC_E + (size_t)(b * 8 + h) * 256 * 128; V0 = KV + VAC_E + (size_t)(b * 8 + h) * 256 * 128; T0 = 4; K1 = K0; V1 = V0; NT = 4;
    } else { const int i = it - 1280, b = i >> 3, hq = i & 7, kvh = hq >> 2; const size_t r0 = (size_t)b * 256;
      Q = ZQ + r0 * DZ + ZQB + hq * 128; Gt = ZQ + r0 * DZ + ZGB + hq * 128; O = G + r0 * LDH + 1024 + hq * 128;
      K0 = KV + KBC_E + (size_t)(b * 2 + kvh) * 256 * 128; V0 = KV + VBC_E + (size_t)(b * 2 + kvh) * 256 * 128; T0 = 4; K1 = K0; V1 = V0; NT = 4;
    }
    if (it >= 512 && it < 1024) att::attn_item<1>(Q, K0, V0, T0, K1, V1, NT, Gt, O, kr0, rw0, shm);
    else att::attn_item<0>(Q, K0, V0, T0, K1, V1, NT, Gt, O, 0, 0, shm);
    if (!dyn) it += gridDim.x;
  }
}

__global__ void __launch_bounds__(512, 2) hymba_megakernel(Params p) {
  extern __shared__ __attribute__((aligned(16))) unsigned char shm[];
  cg::grid_group grid = cg::this_grid();
#ifndef RP
#define RP 0
#endif
  volatile LAS unsigned* xst = (volatile LAS unsigned*)((LAS unsigned char*)shm + (LDS_BYTES - 16));
  unsigned* xbar = (unsigned*)(p.ws + WS_BAR);
  if (threadIdx.x < 4) xst[threadIdx.x] = 0u;
  if (blockIdx.x == 0) for (int i = threadIdx.x; i < XCD_BAR_WORDS + 64; i += 512) __hip_atomic_store(xbar + i, 0u, __ATOMIC_RELAXED, __HIP_MEMORY_SCOPE_AGENT);
  for (int rep = 0; rep < ((RP & 1) ? 2 : 1); ++rep) { phase0(p, (char*)shm); __syncthreads(); }
  grid.sync();
  const XcdBarrier xb = xcd_barrier_post(xbar, xst);
#define GSYNC() xcd_barrier(xb)
  for (int rep = 0; rep < ((RP & 2) ? 2 : 1); ++rep) phase1(p);
  GSYNC();
  for (int rep = 0; rep < ((RP & 4) ? 2 : 1); ++rep) { pg8::Gemm g; g.A = (const bf16_t*)(p.ws + WS_H); g.Bt = (const bf16_t*)(p.ws + WS_WTIN); g.M = NTOK; g.N = DIN; g.K = DM; g.ld = LDH;
    pg8::StaticOrder S; S.init(g.M, g.N, (int)gridDim.x, (int)blockIdx.x); S.spread = 1;
    Epi1 E; E.ZQ = (bf16_t*)(p.ws + WS_ZQ); E.KV = (bf16_t*)(p.ws + WS_KV); E.out = p.out; E.gq = p.g_q; E.gk = p.g_k; E.ropeC = (const float*)(p.ws + WS_ROPE); E.ropeS = E.ropeC + 64 * 32;
    E.part = (LAS float*)((LAS unsigned char*)shm + pg8::STAGE_BYTES);
    pg8::gemm_phase<Epi1, pg8::StaticOrder>((LAS unsigned char*)shm, g, S, E); }
  { const int G = (int)gridDim.x, rem = (NTOK / 256) * (DIN / 256) % G;
    if (rem) phase0_late(p, (char*)shm, rem, G - rem); else phase0_late(p, (char*)shm, 0, G); }
  GSYNC();
  for (int rep = 0; rep < ((RP & 8) ? 2 : 1); ++rep) phase3(p, (char*)shm);
  GSYNC();
  for (int rep = 0; rep < ((RP & 16) ? 2 : 1); ++rep) { pg8::Gemm g; g.A = (const bf16_t*)(p.ws + WS_H); g.Bt = (const bf16_t*)(p.ws + WS_WTOUT); g.M = NTOK; g.N = DM; g.K = DM; g.ld = LDH;
    pg8::StaticOrder S; S.init(g.M, g.N, (int)gridDim.x, (int)blockIdx.x);
    Epi2 E; E.xp = p.x_prompt; E.xs = p.x_sample; E.mod = (const float*)(p.ws + WS_MOD); E.Y = (bf16_t*)(p.ws + WS_ZQ);
    pg8::gemm_phase<Epi2, pg8::StaticOrder>((LAS unsigned char*)shm, g, S, E); }
  GSYNC();
  phase5(p);
}

extern "C" void kernel_launch(void* const* d_in, const int* in_sizes, int n_in, void* d_out, int out_size, void* d_ws, size_t ws_size, hipStream_t stream) {
  static int grid_blocks = 0;
  if (!grid_blocks) {
    if (ws_size < WS_END) { fprintf(stderr, "kernel_launch: workspace too small: %zu < %zu\n", ws_size, (size_t)WS_END); return; }
    if (hipFuncSetAttribute((const void*)hymba_megakernel, hipFuncAttributeMaxDynamicSharedMemorySize, LDS_BYTES) != hipSuccess) { fprintf(stderr, "kernel_launch: hipFuncSetAttribute failed\n"); return; }
    int dev = 0, cus = 0, per_cu = 0;
    (void)hipGetDevice(&dev); (void)hipDeviceGetAttribute(&cus, hipDeviceAttributeMultiprocessorCount, dev);
    (void)hipOccupancyMaxActiveBlocksPerMultiprocessor(&per_cu, hymba_megakernel, 512, LDS_BYTES);
    if (per_cu < 1 || cus < 1) { fprintf(stderr, "kernel_launch: occupancy query says %d blocks/CU on %d CUs\n", per_cu, cus); return; }
    grid_blocks = cus;
  }
  Params p{};
  p.x_prompt = (const float*)d_in[0]; p.x_sample = (const float*)d_in[1]; p.cak = (const float*)d_in[2]; p.cav = (const float*)d_in[3]; p.cbk = (const float*)d_in[4]; p.cbv = (const float*)d_in[5];
  p.c = (const float*)d_in[6]; p.c_ctx = (const float*)d_in[7]; p.w_ada = (const float*)d_in[8]; p.b_ada = (const float*)d_in[9]; p.g_norm = (const float*)d_in[10]; p.w_in = (const float*)d_in[11];
  p.rpb = (const float*)d_in[12]; p.g_q = (const float*)d_in[13]; p.g_k = (const float*)d_in[14]; p.w_out = (const float*)d_in[15]; p.g_final = (const float*)d_in[16];
  p.out = (float*)d_out; p.ws = (unsigned char*)d_ws;
  void* args[] = {&p};
  hipError_t e = hipLaunchCooperativeKernel((const void*)hymba_megakernel, dim3(grid_blocks), dim3(512), args, LDS_BYTES, stream);
  if (e != hipSuccess) fprintf(stderr, "cooperative launch failed: %s (grid %d)\n", hipGetErrorString(e), grid_blocks);
}
```

```cpp
#include <hip/hip_runtime.h>
#include <hip/hip_cooperative_groups.h>
#include <cstdio>
#include <cstdint>
namespace cg = cooperative_groups;

constexpr int NTOK = 24576, NPR = 8192, DM = 2048, DIN = 6656;
constexpr int DZ = 4224, LDH = 2112,     ZQA = 0, ZGA = 1024, ZQB = 2048, ZGB = 3072;
constexpr size_t OUT_YP = 0, OUT_YS = 16777216, OUT_AK = 50331648, OUT_AV = 58720256, OUT_BK = 67108864, OUT_BV = 69206016;
constexpr size_t WS_H = 0;
constexpr size_t WS_ZQ = WS_H + (size_t)NTOK * LDH * 2;
constexpr size_t WS_KV = WS_ZQ + (size_t)NTOK * DZ * 2;
constexpr size_t KAC_E = 0, VAC_E = 8388608, KBC_E = 16777216, VBC_E = 18874368, KAL_E = 20971520, VAL_E = 37748736, KBL_E = 54525952, VBL_E = 58720256, KV_E = 62914560;
constexpr size_t WS_WTIN = WS_KV + KV_E * 2;
constexpr size_t WS_WTOUT = WS_WTIN + (size_t)DIN * LDH * 2;
constexpr size_t WS_CACHE = WS_WTOUT + (size_t)DM * LDH * 2;
constexpr size_t CAK_E = 0, CAV_E = 4194304, CBK_E = 8388608, CBV_E = 9437184, CACHE_E = 10485760;
constexpr size_t WS_MOD = WS_CACHE + CACHE_E * 2;
constexpr size_t WS_ROPE = WS_MOD + 9 * 6144 * 4;
constexpr size_t WS_BAR = WS_ROPE + 2 * 64 * 32 * 4;
constexpr size_t WS_CTR = WS_BAR + 3456 * 4;
constexpr size_t WS_END = WS_CTR + 256;
constexpr int LDS_BYTES = 147456;

struct Params {
  const float *x_prompt, *x_sample, *cak, *cav, *cbk, *cbv, *c, *c_ctx, *w_ada, *b_ada, *g_norm, *w_in, *rpb, *g_q, *g_k, *w_out, *g_final;
  float* out; unsigned char* ws;
};

namespace pg8 {
#define PG8_LAS __attribute__((address_space(3)))
typedef unsigned short bf16_t;
typedef short bf16x8 __attribute__((ext_vector_type(8)));
typedef float f32x4 __attribute__((ext_vector_type(4)));
typedef unsigned u32x4 __attribute__((ext_vector_type(4)));
constexpr int BM = 256, BK = 64, HALF = 128, HTB = HALF * BK * 2  , STAGE_BYTES = 8 * HTB, NXCD = 8, WGM = 8;

__host__ __device__ __forceinline__ int lds_byte(int r, int c) { const int st = (r >> 4) * 2 + (c >> 5), rr = r & 15, cc = c & 31, ob = rr * 64 + cc * 2; return st * 1024 + (ob ^ (((ob >> 9) & 1) << 5)); }
__host__ __device__ __forceinline__ void stage_rc(int b, int& R, int& C) { const int st = b / 1024, sb = b % 1024, swz = sb ^ (((sb >> 9) & 1) << 5); R = (st >> 1) * 16 + swz / 64; C = (st & 1) * 32 + (swz % 64) / 2; }
__host__ __device__ __forceinline__ int perm32(int rho) { const int n = rho >> 4, i = rho & 15; return 8 * (i >> 2) + 4 * n + (i & 3); }

struct Unit { int pm, pn; };
struct Gemm { const bf16_t* A; const bf16_t* Bt; int M, N, K, ld; };

struct StaticOrder {
    int nM, nN, nwg, G, c, spread;
    __host__ __device__ void init(int M, int N, int G_, int c_) { nM = M / BM; nN = N / BM; nwg = nM * nN; G = G_; c = c_; spread = 0; }
    __host__ __device__ bool next(int i, Unit& u) const {
        const long L = (long)i * G + c; if (L >= nwg) return false;
        int wgid = (int)L; { const int q = nwg / NXCD, r = nwg % NXCD, xcd = wgid % NXCD, off = wgid / NXCD; wgid = (xcd < r ? xcd * (q + 1) : r * (q + 1) + (xcd - r) * q) + off; }
        const int nig = WGM * nN, gid = wgid / nig, fm = gid * WGM, gsz = (nM - fm) < WGM ? (nM - fm) : WGM;
        u.pn = (wgid % nig) / gsz;
        if (!spread) { u.pm = fm + ((wgid % nig) % gsz); return true; }
        const int lr = fm + ((wgid % nig) % gsz + u.pn) % gsz;
        if (nM != 96) { u.pm = lr; return true; }
        const int blk = lr / 24, o = lr - 24 * blk;
        u.pm = o < 4 ? 8 * blk + o : (o >= 16 && o < 20) ? 8 * blk + 4 + (o - 16) : 32 + 16 * blk + (o < 16 ? o - 4 : o - 8);
        return true;
    }
    __device__ __forceinline__ void a_ready(const Unit&) const {}
    __device__ __forceinline__ void done(const Unit&) const {}
};

template <class Epi, class Sched>
__device__ __forceinline__ void gemm_phase(PG8_LAS unsigned char* lds, const Gemm g, const Sched& S, const Epi& E) {
    int tid = threadIdx.x; asm volatile("" : "+v"(tid)); const int wid = __builtin_amdgcn_readfirstlane(tid >> 6), lane = tid & 63, wr = wid >> 2, wc = wid & 3, fr = lane & 15, fq = lane >> 4;
    const int K = g.K, nt = K / BK, LD = g.ld;
    unsigned voffA[2], voffB[2];
#pragma unroll
    for (int i = 0; i < 2; ++i) { int R, C; stage_rc(tid * 16 + i * 8192, R, C); const int Rb = Epi::PERM ? ((R & ~31) + perm32(R & 31)) : R;
        voffA[i] = (unsigned)(R * LD + C) * 2u; voffB[i] = (unsigned)(Rb * LD + C) * 2u; }
    const size_t kstep = (size_t)(BK * 2);
    const size_t hstep = (size_t)HALF * LD * 2;
    const size_t tstep = 2 * hstep;
    const unsigned ldsw = (unsigned)wid * 1024u;
    const int aoff = lds_byte(wr * 64 + fr, fq * 8), boff = lds_byte(wc * 32 + fr, fq * 8);
#define PG8_SA(b, h) (((b) * 2 + (h)) * HTB)
#define PG8_SB(b, h) ((4 + (b) * 2 + (h)) * HTB)
#define PG8_STAGE(bufoff, gbase, voff) do { _Pragma("unroll") for (int _i = 0; _i < 2; ++_i) \
        __builtin_amdgcn_global_load_lds((const unsigned*)((const char*)(gbase) + (voff)[_i]), (PG8_LAS unsigned*)(lds + (bufoff) + ldsw + _i * 8192), 16, 0, 0); } while (0)
#define PG8_LDA(dst, b, h) do { _Pragma("unroll") for (int m = 0; m < 4; ++m) _Pragma("unroll") for (int k = 0; k < 2; ++k) dst[m][k] = *(const PG8_LAS bf16x8*)(lds + PG8_SA(b, h) + aoff + m * 2048 + k * 1024); } while (0)
#define PG8_LDB(dst, b, h) do { _Pragma("unroll") for (int n = 0; n < 2; ++n) _Pragma("unroll") for (int k = 0; k < 2; ++k) dst[n][k] = *(const PG8_LAS bf16x8*)(lds + PG8_SB(b, h) + boff + n * 2048 + k * 1024); } while (0)
#define PG8_MMA(ai, bj, At, Bt) do { __builtin_amdgcn_s_setprio(1); _Pragma("unroll") for (int m = 0; m < 4; ++m) _Pragma("unroll") for (int n = 0; n < 2; ++n) _Pragma("unroll") for (int k = 0; k < 2; ++k) \
        acc[ai][bj][m][n] = __builtin_amdgcn_mfma_f32_16x16x32_bf16(Bt[n][k], At[m][k], acc[ai][bj][m][n], 0, 0, 0); __builtin_amdgcn_s_setprio(0); } while (0)
#define PG8_WAIT_V(n) asm volatile("s_waitcnt vmcnt(" #n ")" ::: "memory")
#define PG8_WAIT_L(n) asm volatile("s_waitcnt lgkmcnt(" #n ")" ::: "memory")
#define PG8_BAR __builtin_amdgcn_s_barrier()
#define PG8_SCHED __builtin_amdgcn_sched_barrier(0)
    Unit cur, nxt; int ui = 0;
    if (!S.next(0, cur)) return;
    f32x4 acc[2][2][4][2];
#pragma unroll
    for (int a = 0; a < 2; ++a)
#pragma unroll
        for (int b = 0; b < 2; ++b)
#pragma unroll
            for (int m = 0; m < 4; ++m)
#pragma unroll
                for (int n = 0; n < 2; ++n) acc[a][b][m][n] = (f32x4){0.f, 0.f, 0.f, 0.f};
    bf16x8 At[4][2], B0[2][2], B1[2][2];
    const char* cA = (const char*)g.A + (size_t)cur.pm * tstep; const char* cB = (const char*)g.Bt + (size_t)cur.pn * tstep;
    S.a_ready(cur);
    PG8_STAGE(PG8_SB(0, 0), cB, voffB); PG8_STAGE(PG8_SA(0, 0), cA, voffA); PG8_STAGE(PG8_SB(0, 1), cB + hstep, voffB); PG8_STAGE(PG8_SA(0, 1), cA + hstep, voffA);
    if (wr == 1) PG8_BAR;
    PG8_WAIT_V(4); PG8_BAR;
    PG8_STAGE(PG8_SB(1, 0), cB + kstep, voffB); PG8_STAGE(PG8_SA(1, 0), cA + kstep, voffA); PG8_STAGE(PG8_SB(1, 1), cB + hstep + kstep, voffB);
    PG8_WAIT_V(6); PG8_BAR;
    for (;;) {
        const bool has_next = S.next(ui + 1, nxt);
        const char* nA = has_next ? (const char*)g.A + (size_t)nxt.pm * tstep : cA; const char* nB = has_next ? (const char*)g.Bt + (size_t)nxt.pn * tstep : cB;
        for (int t = 0; t < nt; t += 2) {
            const bool last = (t == nt - 2);
            const char* a1 = cA + (size_t)(t + 1) * kstep;
            const char* a2 = last ? nA : cA + (size_t)(t + 2) * kstep; const char* b2 = last ? nB : cB + (size_t)(t + 2) * kstep;
            const char* a3 = a2 + kstep; const char* b3 = b2 + kstep;
            if (last && has_next) S.a_ready(nxt);
            PG8_LDB(B0, 0, 0); PG8_SCHED; PG8_LDA(At, 0, 0); PG8_STAGE(PG8_SA(1, 1), a1 + hstep, voffA);
            PG8_WAIT_L(8); PG8_BAR; PG8_WAIT_L(0); PG8_MMA(0, 0, At, B0); PG8_BAR; PG8_SCHED;
            PG8_LDB(B1, 0, 1); PG8_STAGE(PG8_SB(0, 0), b2, voffB);
            PG8_BAR; PG8_WAIT_L(0); PG8_MMA(0, 1, At, B1); PG8_BAR;
            PG8_LDA(At, 0, 1); PG8_STAGE(PG8_SA(0, 0), a2, voffA);
            PG8_BAR; PG8_WAIT_L(0); PG8_MMA(1, 0, At, B0); PG8_BAR; PG8_SCHED;
            PG8_STAGE(PG8_SB(0, 1), b2 + hstep, voffB);
            PG8_WAIT_V(6); PG8_BAR; PG8_MMA(1, 1, At, B1); PG8_BAR;
            PG8_LDB(B0, 1, 0); PG8_SCHED; PG8_LDA(At, 1, 0); PG8_STAGE(PG8_SA(0, 1), a2 + hstep, voffA);
            PG8_WAIT_L(8); PG8_BAR; PG8_WAIT_L(0); PG8_MMA(0, 0, At, B0); PG8_BAR; PG8_SCHED;
            PG8_LDB(B1, 1, 1); PG8_STAGE(PG8_SB(1, 0), b3, voffB);
            PG8_BAR; PG8_WAIT_L(0); PG8_MMA(0, 1, At, B1); PG8_BAR;
            PG8_LDA(At, 1, 1); PG8_STAGE(PG8_SA(1, 0), a3, voffA);
            PG8_BAR; PG8_WAIT_L(0); PG8_MMA(1, 0, At, B0); PG8_BAR; PG8_SCHED;
            PG8_STAGE(PG8_SB(1, 1), b3 + hstep, voffB);
            PG8_WAIT_V(6); PG8_BAR; PG8_MMA(1, 1, At, B1); PG8_BAR;
        }
        if constexpr (!Epi::AFTER_DRAIN) { E(acc, cur, wr, wc, fr, fq); S.done(cur); }
        if (!has_next) break;
#pragma unroll
        for (int a = 0; a < 2; ++a)
#pragma unroll
            for (int b = 0; b < 2; ++b)
#pragma unroll
                for (int m = 0; m < 4; ++m)
#pragma unroll
                    for (int n = 0; n < 2; ++n) acc[a][b][m][n] = (f32x4){0.f, 0.f, 0.f, 0.f};
        cur = nxt; cA = nA; cB = nB; ++ui;
    }
    PG8_WAIT_V(0);
    if (wr == 0) PG8_BAR;
    PG8_BAR;
    if constexpr (Epi::AFTER_DRAIN) { E.fused(acc, cur, wr, wc, fr, fq, lds, wid, lane); S.done(cur); }
#undef PG8_SA
#undef PG8_SB
#undef PG8_STAGE
#undef PG8_LDA
#undef PG8_LDB
#undef PG8_MMA
#undef PG8_WAIT_V
#undef PG8_WAIT_L
#undef PG8_BAR
#undef PG8_SCHED
}
}

typedef unsigned short bf16_t;
typedef float f32x4 __attribute__((ext_vector_type(4)));
typedef float f32x8 __attribute__((ext_vector_type(8)));
typedef unsigned u32x4 __attribute__((ext_vector_type(4)));
typedef unsigned u32x2 __attribute__((ext_vector_type(2)));
#define LAS __attribute__((address_space(3)))
__device__ __forceinline__ unsigned cvtpk(float lo, float hi) { unsigned r; asm volatile("v_cvt_pk_bf16_f32 %0, %1, %2" : "=v"(r) : "v"(lo), "v"(hi)); return r; }
__device__ __forceinline__ float bf2f(bf16_t b) { return __uint_as_float(((unsigned)b) << 16); }
__device__ __forceinline__ void store4bf(bf16_t* p, f32x4 v) { u32x2 w = {cvtpk(v[0], v[1]), cvtpk(v[2], v[3])}; *(u32x2*)p = w; }
__device__ __forceinline__ int opaque_tid() { int t = threadIdx.x; asm volatile("" : "+v"(t)); return t; }
__device__ __forceinline__ float siluf(float v) { return v * __builtin_amdgcn_rcpf(1.f + __builtin_amdgcn_exp2f(v * -1.4426950408889634f)); }

struct Epi1 {
  static constexpr bool PERM = false, AFTER_DRAIN = false;
  bf16_t* ZQ; bf16_t* KV; float* out; const float* gq; const float* gk; const float* ropeC; const float* ropeS; LAS float* part;
  __device__ __forceinline__ void operator()(const f32x4 (&acc)[2][2][4][2], const pg8::Unit& u, int wr, int wc, int fr, int fq) const {
    const int pn = u.pn, pm = u.pm; const bool ctx = pm < 32;
    const int fbase = 64 * (wc >> 1) + 16 * (wc & 1) + 8 * (fq & 1) + 4 * (fq >> 1), tok0 = 64 * wr + fr;
    bf16_t* dst; int rs, hs; float* ob = nullptr; int nh = 0, h0 = 0; int kind = 0;
    const int lb = (pm - 32) >> 3, lt = ((pm - 32) & 7) * 256;
    if (pn < 4) { dst = ZQ + (size_t)pm * 256 * DZ + ZQA + pn * 256; rs = DZ; hs = 128; }
    else if (pn < 12 || pn == 20 || pn == 21) {
      size_t ec, el;
      if (pn < 8) { ec = KAC_E; el = KAL_E; nh = 8; h0 = 2 * (pn - 4); if (ctx) ob = out + OUT_AK; }
      else if (pn < 12) { ec = VAC_E; el = VAL_E; nh = 8; h0 = 2 * (pn - 8); if (ctx) ob = out + OUT_AV; }
      else if (pn == 20) { ec = KBC_E; el = KBL_E; nh = 2; h0 = 0; kind = 2; if (ctx) ob = out + OUT_BK; }
      else { ec = VBC_E; el = VBL_E; nh = 2; h0 = 0; if (ctx) ob = out + OUT_BV; }
      rs = 128;
      if (ctx) { dst = KV + ec + ((size_t)(pm * nh + h0) * 256) * 128; hs = 256 * 128; }
      else { dst = KV + el + ((size_t)(lb * nh + h0) * 2048 + lt) * 128; hs = 2048 * 128; }
    }
    else if (pn < 16) { dst = ZQ + (size_t)pm * 256 * DZ + ZGA + (pn - 12) * 256; rs = DZ; hs = 128; kind = 1; }
    else if (pn < 20) { dst = ZQ + (size_t)pm * 256 * DZ + ZQB + (pn - 16) * 256; rs = DZ; hs = 128; kind = 2; }
    else { dst = ZQ + (size_t)pm * 256 * DZ + ZGB + (pn - 22) * 256; rs = DZ; hs = 128; kind = 1; }
    const int fb = (kind == 2) ? fbase : 32 * wc + 8 * fq;
    dst += (size_t)tok0 * rs + fb;
    if (ob) ob += ((size_t)(pm * nh + h0) * 256 + tok0) * 128 + fb;
    if (kind == 0) {
#pragma unroll
      for (int ai = 0; ai < 2; ++ai)
#pragma unroll
        for (int m = 0; m < 4; ++m) { const int dt = 128 * ai + 16 * m;
#pragma unroll
          for (int bj = 0; bj < 2; ++bj) { const f32x4 v0 = acc[ai][bj][m][0], v1 = acc[ai][bj][m][1];
            u32x4 w = {cvtpk(v0[0], v0[1]), cvtpk(v0[2], v0[3]), cvtpk(v1[0], v1[1]), cvtpk(v1[2], v1[3])};
            *(u32x4*)(dst + (size_t)dt * rs + bj * hs) = w;
            if (ob) { float* op = ob + ((size_t)bj * 256 + dt) * 128; *(f32x4*)op = v0; *(f32x4*)(op + 4) = v1; } } }
    } else if (kind == 1) {
#pragma unroll
      for (int ai = 0; ai < 2; ++ai)
#pragma unroll
        for (int m = 0; m < 4; ++m) { const int dt = 128 * ai + 16 * m;
#pragma unroll
          for (int bj = 0; bj < 2; ++bj) { const f32x4 v0 = acc[ai][bj][m][0], v1 = acc[ai][bj][m][1];
            u32x4 w = {cvtpk(siluf(v0[0]), siluf(v0[1])), cvtpk(siluf(v0[2]), siluf(v0[3])), cvtpk(siluf(v1[0]), siluf(v1[1])), cvtpk(siluf(v1[2]), siluf(v1[3]))};
            *(u32x4*)(dst + (size_t)dt * rs + bj * hs) = w; } }
    } else {
      const float* g = (pn == 20) ? gk : gq;
      const f32x4 g0 = *(const f32x4*)(g + fbase), g1 = *(const f32x4*)(g + fbase + 32);
      const int i0 = 16 * (wc & 1) + 8 * (fq & 1) + 4 * (fq >> 1); const bool colhalf = (wc >> 1) != 0;
      f32x4 cs4[4], sn4[4];
#pragma unroll
      for (int k = 0; k < 4; ++k) { const int pos = ctx ? 0 : (colhalf ? (16 * k + fr) : (((pm - 32) & 7) * 4 + 2 * (k & 1) + wr));
        cs4[k] = *(const f32x4*)(ropeC + pos * 32 + i0); sn4[k] = *(const f32x4*)(ropeS + pos * 32 + i0); }
#pragma unroll
      for (int bj = 0; bj < 2; ++bj)
#pragma unroll
        for (int ai = 0; ai < 2; ++ai)
#pragma unroll
          for (int m = 0; m < 4; ++m) { const f32x4 a = acc[ai][bj][m][0], b = acc[ai][bj][m][1];
            float s = a[0] * a[0] + a[1] * a[1] + a[2] * a[2] + a[3] * a[3] + b[0] * b[0] + b[1] * b[1] + b[2] * b[2] + b[3] * b[3];
            s += __shfl_xor(s, 16); s += __shfl_xor(s, 32);
            if (fq == 0) part[((wr * 4 + wc) * 16 + (bj * 8 + ai * 4 + m)) * 16 + fr] = s; }
      asm volatile("s_waitcnt lgkmcnt(0)" ::: "memory"); __builtin_amdgcn_s_barrier(); asm volatile("" ::: "memory");
      const int fst = 64 * (wc >> 1) + 16 * (wc & 1) + 8 * (fq & 1) + 32 * (fq >> 1) - fbase;
#pragma unroll
      for (int ai = 0; ai < 2; ++ai)
#pragma unroll
        for (int m = 0; m < 4; ++m) { const int dt = 128 * ai + 16 * m;
          const f32x4 cs = colhalf ? cs4[m] : cs4[ai], sn = colhalf ? sn4[m] : sn4[ai];
#pragma unroll
          for (int bj = 0; bj < 2; ++bj) { const int idx = (bj * 8 + ai * 4 + m) * 16 + fr;
            const float t = part[(wr * 4 + 0) * 256 + idx] + part[(wr * 4 + 1) * 256 + idx] + part[(wr * 4 + 2) * 256 + idx] + part[(wr * 4 + 3) * 256 + idx];
            const float r = rsqrtf(t * (1.f / 128.f) + 1e-6f);
            const f32x4 x1 = acc[ai][bj][m][0] * r * g0, x2 = acc[ai][bj][m][1] * r * g1;
            const f32x4 o1 = x1 * cs - x2 * sn, o2 = x2 * cs + x1 * sn;
            { const unsigned a0 = cvtpk(o1[0], o1[1]), a1 = cvtpk(o1[2], o1[3]), b0 = cvtpk(o2[0], o2[1]), b1 = cvtpk(o2[2], o2[3]);
              auto r0 = __builtin_amdgcn_permlane32_swap(a0, b0, false, false); auto r1 = __builtin_amdgcn_permlane32_swap(a1, b1, false, false);
              u32x4 w = {r0[0], r1[0], r0[1], r1[1]}; *(u32x4*)(dst + (size_t)dt * rs + bj * hs + fst) = w; }
            if (ob) { float* op = ob + ((size_t)bj * 256 + dt) * 128; *(f32x4*)op = o1; *(f32x4*)(op + 32) = o2; } } }
    }
  }
};
struct Epi2 {
  static constexpr bool PERM = false, AFTER_DRAIN = false;
  const float* xp; const float* xs; const float* mod; bf16_t* Y;
  __device__ __forceinline__ void operator()(const f32x4 (&acc)[2][2][4][2], const pg8::Unit& u, int wr, int wc, int fr, int fq) const {
    const int row0 = u.pm * 256 + 64 * wr + fr, c0 = u.pn * 256 + wc * 32 + 8 * fq;
    const int v = row0 < NPR ? 8 : ((row0 - NPR) >> 11);
    const float* gt = mod + v * 6144 + 4096 + c0;
    const f32x4 ga0 = *(const f32x4*)gt, ga1 = *(const f32x4*)(gt + 4), gb0 = *(const f32x4*)(gt + 128), gb1 = *(const f32x4*)(gt + 132);
    constexpr int XB = 4;
#pragma unroll
    for (int g0 = 0; g0 < 8; g0 += XB) {
      f32x4 xv[XB][2][2];
#pragma unroll
      for (int g = 0; g < XB; ++g) { const int ai = (g0 + g) >> 2, m = (g0 + g) & 3, row = row0 + 128 * ai + 16 * m;
        const float* xr = (row < NPR ? xp + (size_t)row * DM : xs + (size_t)(row - NPR) * DM) + c0;
#pragma unroll
        for (int bj = 0; bj < 2; ++bj) { xv[g][bj][0] = *(const f32x4*)(xr + bj * 128); xv[g][bj][1] = *(const f32x4*)(xr + bj * 128 + 4); } }
#pragma unroll
      for (int g = 0; g < XB; ++g) { const int ai = (g0 + g) >> 2, m = (g0 + g) & 3, row = row0 + 128 * ai + 16 * m; bf16_t* orow = Y + (size_t)row * DM + c0;
#pragma unroll
        for (int bj = 0; bj < 2; ++bj) { const f32x4 y0 = xv[g][bj][0] + (bj ? gb0 : ga0) * acc[ai][bj][m][0], y1 = xv[g][bj][1] + (bj ? gb1 : ga1) * acc[ai][bj][m][1];
          u32x4 w = {cvtpk(y0[0], y0[1]), cvtpk(y0[2], y0[3]), cvtpk(y1[0], y1[1]), cvtpk(y1[2], y1[3])};
          *(u32x4*)(orow + bj * 128) = w; } }
    }
  }
};

#define XB_TMO      128
#define XB_XCNT(j)  (256  + 64 * (j))
#define XB_XSUB(j)  (1280 + 64 * (j))
#define XB_XGEN(j)  (2304 + 64 * (j))
#define XB_TOP      3328
#define XB_TOPGEN   3392
#define XCD_BAR_WORDS 3456
#define XB_SPIN_CAP (1u << 18)
__device__ __forceinline__ unsigned xb_ld(unsigned* p)              { return __hip_atomic_load(p, __ATOMIC_RELAXED, __HIP_MEMORY_SCOPE_AGENT); }
__device__ __forceinline__ unsigned xb_add(unsigned* p, unsigned v) { return __hip_atomic_fetch_add(p, v, __ATOMIC_RELAXED, __HIP_MEMORY_SCOPE_AGENT); }
__device__ __forceinline__ unsigned xb_xcc_id() { return (unsigned)__builtin_amdgcn_s_getreg((3 << 11) | 20) & 0xFu; }
#define XB_SPIN(cond, bar) do { unsigned _sp = 0; while (cond) { __builtin_amdgcn_s_sleep(1); \
    if ((++_sp & 255u) == 0u) { if (xb_ld(&(bar)[XB_TMO])) break; if (_sp > XB_SPIN_CAP) { atomicAdd(&(bar)[XB_TMO], 1u); break; } } } } while (0)
struct XcdBarrier { unsigned* bar; unsigned x; volatile LAS unsigned* st; };
__device__ __forceinline__ XcdBarrier xcd_barrier_post(unsigned* bar, volatile LAS unsigned* st) {
    XcdBarrier b; b.bar = bar; b.x = xb_xcc_id(); b.st = st;
    if (threadIdx.x == 0) (void)xb_add(&bar[XB_XCNT(b.x)], 1u);
    return b;
}
__device__ __forceinline__ void xcd_barrier_complete(unsigned* bar, unsigned x, unsigned& nloc, unsigned& nx) {
    const unsigned G = gridDim.x * gridDim.y * gridDim.z;
    unsigned sum, cnt, mine, sp = 0u;
    for (;;) {
        sum = 0u; cnt = 0u; mine = 0u;
#pragma unroll
        for (unsigned j = 0; j < 16; ++j) { const unsigned c = xb_ld(&bar[XB_XCNT(j)]); sum += c; cnt += (c > 0u) ? 1u : 0u; mine = (j == x) ? c : mine; }
        if (sum == G) break;
        __builtin_amdgcn_s_sleep(1);
        if ((++sp & 255u) == 0u) { if (xb_ld(&bar[XB_TMO])) break; if (sp > XB_SPIN_CAP) { atomicAdd(&bar[XB_TMO], 1u); break; } }
    }
    nloc = mine > 0u ? mine : 1u; nx = cnt > 0u ? cnt : 1u;
}
__device__ __forceinline__ void xcd_barrier(const XcdBarrier& b) {
    asm volatile("s_waitcnt vmcnt(0)" ::: "memory");
    __syncthreads();
    if (threadIdx.x == 0) {
        unsigned* bar = b.bar;
        __builtin_amdgcn_s_waitcnt(0);
        unsigned nloc = b.st[0], nx = b.st[1];
        if (nloc == 0u) { xcd_barrier_complete(bar, b.x, nloc, nx); b.st[0] = nloc; b.st[1] = nx; }
        const unsigned old = xb_add(&bar[XB_XSUB(b.x)], 1u);
        const unsigned gen = old / nloc;
        if (old + 1u == (gen + 1u) * nloc) {
            __builtin_amdgcn_fence(__ATOMIC_RELEASE, "agent");
            asm volatile("s_waitcnt vmcnt(0)" ::: "memory");
            const unsigned og = xb_add(&bar[XB_TOP], 1u);
            const unsigned tg = og / nx;
            if (og + 1u == (tg + 1u) * nx) xb_add(&bar[XB_TOPGEN], 1u);
            else XB_SPIN(xb_ld(&bar[XB_TOPGEN]) == tg, bar);
            __builtin_amdgcn_fence(__ATOMIC_ACQUIRE, "agent");
            xb_add(&bar[XB_XGEN(b.x)], 1u);
            asm volatile("s_waitcnt vmcnt(0)" ::: "memory");
        } else {
            XB_SPIN(xb_ld(&bar[XB_XGEN(b.x)]) == gen, bar);
            __builtin_amdgcn_fence(__ATOMIC_ACQUIRE, "agent");
            asm volatile("s_waitcnt vmcnt(0)" ::: "memory");
        }
    }
    __syncthreads();
}

namespace att {
using bf16x8 = __attribute__((ext_vector_type(8))) short;
using s16x4  = __attribute__((ext_vector_type(4))) short;
using f32x16 = __attribute__((ext_vector_type(16))) float;
constexpr int D = 128, NW = 8, QBLK = 32, KVBLK = 64;
constexpr float SCALE = 0.088388347648318440f;
constexpr float THR = 8.f;
constexpr size_t SHM_V = KVBLK * D * 2, SHM_K = KVBLK * D * 2;
constexpr size_t OFF_WS = 2 * SHM_V + 2 * SHM_K, OFF_BIAS = OFF_WS + NW * 64 * 4;
constexpr size_t OFF_TEDGE = OFF_BIAS + 15 * 128 * 4, OFF_RPB = OFF_TEDGE + 15 * 15 * 64 * 4;
#define KSWZ(row, colB) ((row) * 256 + ((colB) ^ (((row) & 7) << 4)))
#define SBAR() __builtin_amdgcn_sched_barrier(0)
__device__ __forceinline__ int crow(int r, int hi) { return (r & 3) + 8 * (r >> 2) + 4 * hi; }
__device__ __forceinline__ void partialSM(f32x16& p0, f32x16& p1, float& m_reg, float& mn, float& alpha) {
  constexpr float C = SCALE * 1.4426950408889634f;
  float pmax = p0[0]; for (int r = 1; r < 16; ++r) pmax = fmaxf(pmax, p0[r]); for (int r = 0; r < 16; ++r) pmax = fmaxf(pmax, p1[r]);
  { auto rr = __builtin_amdgcn_permlane32_swap(__float_as_uint(pmax), __float_as_uint(pmax), false, false);
    pmax = fmaxf(__uint_as_float(rr[0]), __uint_as_float(rr[1])); }
  if (__builtin_expect(__all(pmax - m_reg <= THR / SCALE), 1)) { mn = m_reg; alpha = 1.f; }
  else { mn = fmaxf(m_reg, pmax); alpha = __builtin_amdgcn_exp2f((m_reg - mn) * C); m_reg = mn; }
  float mnC = -mn * C;
  for (int r = 0; r < 16; ++r) p0[r] = fmaf(p0[r], C, mnC); for (int r = 0; r < 16; ++r) p1[r] = fmaf(p1[r], C, mnC);
  for (int r = 0; r < 16; ++r) p0[r] = __builtin_amdgcn_exp2f(p0[r]);
}
__device__ __forceinline__ void finishSM(f32x16& p0, f32x16& p1, float alpha, float& l_reg, bf16x8& pa0, bf16x8& pa1, bf16x8& pa2, bf16x8& pa3) {
  for (int r = 0; r < 16; ++r) p1[r] = __builtin_amdgcn_exp2f(p1[r]);
  float ps = 0; for (int r = 0; r < 16; ++r) ps += p0[r]; for (int r = 0; r < 16; ++r) ps += p1[r];
  { auto rr = __builtin_amdgcn_permlane32_swap(__float_as_uint(ps), __float_as_uint(ps), false, false);
    ps = __uint_as_float(rr[0]) + __uint_as_float(rr[1]); }
  l_reg = l_reg * alpha + ps;
#define PK4(P, BASE, OUT) do { unsigned a0 = cvtpk(P[BASE + 0], P[BASE + 1]), a1 = cvtpk(P[BASE + 2], P[BASE + 3]);   \
    unsigned b0 = cvtpk(P[BASE + 4], P[BASE + 5]), b1 = cvtpk(P[BASE + 6], P[BASE + 7]);                              \
    auto r0 = __builtin_amdgcn_permlane32_swap(a0, b0, false, false); auto r1 = __builtin_amdgcn_permlane32_swap(a1, b1, false, false); \
    u32x4 w = {r0[0], r1[0], r0[1], r1[1]}; OUT = *reinterpret_cast<bf16x8*>(&w); } while (0)
  PK4(p0, 0, pa0); PK4(p0, 8, pa1); PK4(p1, 0, pa2); PK4(p1, 8, pa3);
#undef PK4
}
__device__ __forceinline__ void qkt(f32x16& p0, f32x16& p1, const char* Ks, const bf16x8* qr, int r32, int hi) {
  p0 = f32x16{}; p1 = f32x16{};
  for (int d0 = 0; d0 < 8; ++d0) { int cb = (d0 * 16 + hi * 8) * 2;
    bf16x8 b0 = *reinterpret_cast<const bf16x8*>(Ks + KSWZ(r32, cb));
    bf16x8 b1 = *reinterpret_cast<const bf16x8*>(Ks + KSWZ(32 + r32, cb));
    p0 = __builtin_amdgcn_mfma_f32_32x32x16_bf16(b0, qr[d0], p0, 0, 0, 0);
    p1 = __builtin_amdgcn_mfma_f32_32x32x16_bf16(b1, qr[d0], p1, 0, 0, 0); }
}
__device__ __forceinline__ int v_st(int k, int c) { const int kk = (k & ~0xC) | ((k & 4) << 1) | ((k & 8) >> 1); return ((kk >> 3) * 4 + (c >> 5)) * 512 + ((kk & 7) * 32 + (c & 31)) * 2; }
__device__ __forceinline__ int v_rd_base(int lane) { return ((lane & 3) << 3) | (((lane >> 2) & 3) << 6) | (((lane >> 4) & 1) << 5) | (((lane >> 5) & 1) << 8); }
constexpr int v_rd_off(int d0, int ks, int half) { return d0 * 512 + ks * 4096 + half * 2048; }
template <int OFF> __device__ __forceinline__ s16x4 tr_read(int vb) {
  s16x4 r; asm volatile("ds_read_b64_tr_b16 %0, %1 offset:%2" : "=&v"(r) : "v"(vb), "i"(OFF) : "memory"); return r;
}
template <int D0> __device__ __forceinline__ void pv_one(f32x16& od, int vb, bf16x8 pa0, bf16x8 pa1, bf16x8 pa2, bf16x8 pa3) {
  const s16x4 l0 = tr_read<v_rd_off(D0, 0, 0)>(vb), h0 = tr_read<v_rd_off(D0, 0, 1)>(vb), l1 = tr_read<v_rd_off(D0, 1, 0)>(vb), h1 = tr_read<v_rd_off(D0, 1, 1)>(vb);
  const s16x4 l2 = tr_read<v_rd_off(D0, 2, 0)>(vb), h2 = tr_read<v_rd_off(D0, 2, 1)>(vb), l3 = tr_read<v_rd_off(D0, 3, 0)>(vb), h3 = tr_read<v_rd_off(D0, 3, 1)>(vb);
  asm volatile("s_waitcnt lgkmcnt(0)" ::: "memory"); SBAR();
#define PK(L, H) (bf16x8){L[0], L[1], L[2], L[3], H[0], H[1], H[2], H[3]}
  od = __builtin_amdgcn_mfma_f32_32x32x16_bf16(pa0, PK(l0, h0), od, 0, 0, 0);
  od = __builtin_amdgcn_mfma_f32_32x32x16_bf16(pa1, PK(l1, h1), od, 0, 0, 0);
  od = __builtin_amdgcn_mfma_f32_32x32x16_bf16(pa2, PK(l2, h2), od, 0, 0, 0);
  od = __builtin_amdgcn_mfma_f32_32x32x16_bf16(pa3, PK(l3, h3), od, 0, 0, 0);
#undef PK
}
__device__ __forceinline__ void pv_d0(f32x16* o, int vb, bf16x8 pa0, bf16x8 pa1, bf16x8 pa2, bf16x8 pa3) {
  pv_one<0>(o[0], vb, pa0, pa1, pa2, pa3); pv_one<1>(o[1], vb, pa0, pa1, pa2, pa3); pv_one<2>(o[2], vb, pa0, pa1, pa2, pa3); pv_one<3>(o[3], vb, pa0, pa1, pa2, pa3);
}
__device__ __forceinline__ void nb_hook(f32x16& p0, f32x16& p1, const float* bt) {
#pragma unroll
  for (int r = 0; r < 16; ++r) { const int kc = (r & 3) + 8 * (r >> 2); p0[r] += bt[kc]; p1[r] += bt[kc + 32]; if ((r & 3) == 3) SBAR(); }
}

template <int MODE>
__device__ __forceinline__ void attn_item(const bf16_t* __restrict__ Qb, const bf16_t* __restrict__ K0, const bf16_t* __restrict__ V0, int T0,
                                          const bf16_t* __restrict__ K1, const bf16_t* __restrict__ V1, int NT,
                                          const bf16_t* __restrict__ Gb, bf16_t* __restrict__ Ob, int kr0, int rw0, char* lds) {
  const int tid = opaque_tid(), wid = __builtin_amdgcn_readfirstlane(tid >> 6), lane = tid & 63, r32 = lane & 31, hi = lane >> 5;
  constexpr int NB = (MODE == 0) ? 3 : 2;
  char* V_lds = lds; char* K_lds = lds + NB * SHM_V;
  float* ws = (float*)(lds + 2 * NB * SHM_V) + wid * 64; float* li_l = ws; float* al_l = ws + 32;
  const int rw = rw0 + (wid >> 1), qc = (wid & 1) * 32 + r32, rs = min(max(rw - 4, 0), 24);
  const bool edge = qc < 8 || qc > 56;
  const float* bias0 = edge ? (const float*)(lds + OFF_TEDGE) + (qc < 8 ? qc : qc - 49) * 64 + 4 * hi : (const float*)(lds + OFF_BIAS) + (4 * hi - qc + 63);
  const int bstr = edge ? 960 : 128;
  float m_reg = -1e30f, l_reg = 0; f32x16 o[4] = {}; bf16x8 qr[8];
  const bf16_t* Qw = Qb + (long)(wid * QBLK + r32) * DZ + hi * 8;
#pragma unroll
  for (int d0 = 0; d0 < 8; ++d0) qr[d0] = *reinterpret_cast<const bf16x8*>(Qw + d0 * 16);
  const int sr = tid >> 4, sc = (tid & 15) * 8, vst0 = v_st(sr, sc), vst1 = v_st(32 + sr, sc);
  const int vb0 = (int)(uintptr_t)V_lds + v_rd_base(lane); const int soff = sr * D + sc;
  constexpr int SD = (MODE == 1) ? 1 : 2;
  struct { bf16x8 vs0, vs1, ks0, ks1; } sr_[SD];
#define SLOAD(i, t) do { const int _t = (t); const bool _s1 = _t >= T0; const int _tt = _s1 ? _t - T0 : _t; \
    const bf16_t* _kb = (_s1 ? K1 : K0) + (long)_tt * (KVBLK * D); const bf16_t* _vb = (_s1 ? V1 : V0) + (long)_tt * (KVBLK * D); \
    sr_[i].vs0 = *reinterpret_cast<const bf16x8*>(_vb + soff); sr_[i].vs1 = *reinterpret_cast<const bf16x8*>(_vb + soff + 32 * D); \
    sr_[i].ks0 = *reinterpret_cast<const bf16x8*>(_kb + soff); sr_[i].ks1 = *reinterpret_cast<const bf16x8*>(_kb + soff + 32 * D); } while (0)
#define SWRITE(b, i) do { *(bf16x8*)(V_lds + (b) * SHM_V + vst0) = sr_[i].vs0;          \
    *(bf16x8*)(V_lds + (b) * SHM_V + vst1) = sr_[i].vs1; int kc = sc * 2;               \
    *(bf16x8*)(K_lds + (b) * SHM_K + KSWZ(sr, kc)) = sr_[i].ks0;                       \
    *(bf16x8*)(K_lds + (b) * SHM_K + KSWZ(32 + sr, kc)) = sr_[i].ks1; } while (0)
#define SWAIT() do { if (SD == 2) asm volatile("s_waitcnt vmcnt(4)" ::: "memory"); else asm volatile("s_waitcnt vmcnt(0)" ::: "memory"); } while (0)
#define RESC(a) do { if (__any((a) < 1.f)) { if (hi == 0) al_l[r32] = (a); asm volatile("s_waitcnt lgkmcnt(0)" ::: "memory"); \
    for (int d = 0; d < 4; ++d) for (int r = 0; r < 16; ++r) o[d][r] *= al_l[crow(r, hi)]; } } while (0)
  f32x16 pA0, pA1, pB0, pB1; float mnA, mnB, alA, alB; bf16x8 pa0, pa1, pa2, pa3;
  constexpr int SE = 0, SO = SD - 1;
#define TVAL(t) (MODE == 0 || (t) < T0 || (unsigned)(kr0 + (t) - T0 - rs) < 8u)
#define HALF(VC, VP, pC0, pC1, pP0, pP1, alC, mnC, alP, KOFF, VOFF, TC, DOLOAD, LSLOT, LTILE) do { \
    SBAR(); if (VC) qkt(pC0, pC1, K_lds + (KOFF), qr, r32, hi); \
    if (VP) finishSM(pP0, pP1, alP, l_reg, pa0, pa1, pa2, pa3); SBAR(); \
    if (DOLOAD) SLOAD(LSLOT, LTILE); SBAR(); \
    if (VP) pv_d0(o, vb0 + (int)(VOFF), pa0, pa1, pa2, pa3); \
    if (VC) { if (MODE == 1 && (TC) >= T0) nb_hook(pC0, pC1, bias0 + (kr0 + (TC) - T0 - rw + 7) * bstr); partialSM(pC0, pC1, m_reg, mnC, alC); } else alC = 1.f; } while (0)
#define HALF4(vc, vp, ...) HALF(vc, vp, __VA_ARGS__)
  SLOAD(SE, 0); if (SD == 2) { SLOAD(SO, 1); asm volatile("s_waitcnt vmcnt(4)" ::: "memory"); } else asm volatile("s_waitcnt vmcnt(0)" ::: "memory");
  SWRITE(0, SE); __syncthreads();
  qkt(pA0, pA1, K_lds, qr, r32, hi); partialSM(pA0, pA1, m_reg, mnA, alA);
  if (SD == 2) { if (2 < NT) SLOAD(SE, 2); } else SLOAD(SO, 1);
  SWAIT(); SWRITE(1, SO); __syncthreads();
  bool vA = true, vB;
  int bC = 1, bP = 0;
  for (int j = 1; j + 1 < NT; j += 2) {
    const int bN = (bC + 1 == NB) ? 0 : bC + 1, bNN = (bN + 1 == NB) ? 0 : bN + 1;
    vB = TVAL(j);
    HALF4(vB, vA, pB0, pB1, pA0, pA1, alB, mnB, alA, bC * (int)SHM_K, bP * (int)SHM_V, j, true, SO, j + SD);
    if (NB == 2) __syncthreads();
    SWAIT(); SWRITE(bN, SE);
    RESC(alB); __syncthreads();
    vA = TVAL(j + 1);
    HALF4(vA, vB, pA0, pA1, pB0, pB1, alA, mnA, alB, bN * (int)SHM_K, bC * (int)SHM_V, j + 1, (SD == 1 || j + 3 < NT), SE, j + 1 + SD);
    if (NB == 2) __syncthreads();
    SWAIT(); SWRITE(bNN, SO);
    RESC(alA); __syncthreads();
    bP = bN; bC = bNN;
  }
  vB = TVAL(NT - 1);
  HALF4(vB, vA, pB0, pB1, pA0, pA1, alB, mnB, alA, bC * (int)SHM_K, bP * (int)SHM_V, NT - 1, false, SO, 0);
  __syncthreads(); RESC(alB);
  if (vB) { finishSM(pB0, pB1, alB, l_reg, pa0, pa1, pa2, pa3); SBAR();
    pv_d0(o, vb0 + bC * (int)SHM_V, pa0, pa1, pa2, pa3); }
#undef HALF4
#undef HALF
#undef TVAL
  const bf16_t* Gw = Gb + (long)(wid * QBLK) * DZ; u32x4 gvv[8];
#pragma unroll
  for (int i = 0; i < 8; ++i) { const int c = lane + 64 * i; gvv[i] = *(const u32x4*)(Gw + (c >> 4) * DZ + (c & 15) * 8); }
  if (hi == 0) li_l[r32] = l_reg; asm volatile("s_waitcnt lgkmcnt(0)" ::: "memory");
  float rli[16];
#pragma unroll
  for (int r = 0; r < 16; ++r) rli[r] = __builtin_amdgcn_rcpf(li_l[crow(r, hi)]);
  __syncthreads();
  char* obase = lds + wid * 8192;
#pragma unroll
  for (int r = 0; r < 16; ++r) { const int orow = crow(r, hi);
#pragma unroll
    for (int d0 = 0; d0 < 4; ++d0) *(bf16_t*)(obase + orow * 256 + (d0 * 32 + r32) * 2) = (bf16_t)(cvtpk(o[d0][r] * rli[r], 0.f) & 0xffffu); }
  asm volatile("s_waitcnt lgkmcnt(0)" ::: "memory");
  bf16_t* Ow = Ob + (long)(wid * QBLK) * LDH;
#pragma unroll
  for (int i = 0; i < 8; ++i) { const int c = lane + 64 * i, row = c >> 4, cc = (c & 15) * 8;
    const u32x4 ov = *(const u32x4*)(obase + row * 256 + cc * 2); const u32x4 gv = gvv[i];
    u32x4 w;
#pragma unroll
    for (int q = 0; q < 4; ++q) { const float a0 = __uint_as_float(ov[q] << 16) * __uint_as_float(gv[q] << 16), a1 = __uint_as_float(ov[q] & 0xffff0000u) * __uint_as_float(gv[q] & 0xffff0000u); w[q] = cvtpk(a0, a1); }
    *(u32x4*)(Ow + row * LDH + cc) = w; }
#undef SLOAD
#undef SWRITE
#undef SWAIT
#undef RESC
}
}

__device__ __forceinline__ float wave_sum(float v) {
#pragma unroll
  for (int o = 32; o >= 1; o >>= 1) v += __shfl_xor(v, o);
  return v;
}
constexpr int P0_GEMV = 192, P0_WIN = 1664, P0_WOUT = 512, P0_CACHE = 320, P0_TOTAL = P0_GEMV + P0_WIN + P0_WOUT + P0_CACHE + 1;
__device__ __forceinline__ void p0_gemv(const Params& p, int ci, char* shm) {
  const int tid = opaque_tid(); float* sc = (float*)shm;
  for (int i = tid; i < 9 * 2048; i += 512) { const int v = i >> 11, k = i & 2047; const float cv = v < 8 ? p.c[v * 2048 + k] : p.c_ctx[k]; sc[i] = siluf(cv); }
  __syncthreads();
  const int c4 = tid & 7, kg = tid >> 3;
  f32x4 acc[9];
#pragma unroll
  for (int v = 0; v < 9; ++v) acc[v] = (f32x4){0.f, 0.f, 0.f, 0.f};
  const float* wp = p.w_ada + (size_t)kg * 6144 + ci * 32 + c4 * 4;
#pragma unroll 8
  for (int i = 0; i < 32; ++i) { const f32x4 w = *(const f32x4*)(wp + (size_t)i * 64 * 6144); const int k = kg + 64 * i;
#pragma unroll
    for (int v = 0; v < 9; ++v) acc[v] += w * sc[v * 2048 + k]; }
  __syncthreads();
  float* red = (float*)shm;
#pragma unroll
  for (int v = 0; v < 9; ++v) *(f32x4*)(red + (kg * 9 + v) * 32 + c4 * 4) = acc[v];
  __syncthreads();
  if (tid < 288) { const int v = tid >> 5, cc = tid & 31; float s = 0.f; for (int g = 0; g < 64; ++g) s += red[(g * 9 + v) * 32 + cc];
    const int col = ci * 32 + cc; ((float*)(p.ws + WS_MOD))[v * 6144 + col] = s + p.b_ada[col]; }
  __syncthreads();
}
struct TrItem { const float* src; int ncols; bf16_t* dst; int hb, kc, perm; };
__device__ __forceinline__ TrItem tr_item(const Params& p, int it) {
  TrItem t;
  if (it < P0_GEMV + P0_WIN) { const int i = it - P0_GEMV; t.src = p.w_in; t.ncols = DIN; t.dst = (bf16_t*)(p.ws + WS_WTIN); t.hb = i >> 5; t.kc = i & 31; t.perm = (t.hb >= 32 && t.hb < 42) ? 1 : 2; }
  else { const int i = it - P0_GEMV - P0_WIN; t.src = p.w_out; t.ncols = DM; t.dst = (bf16_t*)(p.ws + WS_WTOUT); t.hb = i >> 5; t.kc = i & 31; t.perm = 2; }
  return t;
}
__device__ __forceinline__ void tr_load(const TrItem& t, int tid, f32x4 (&w)[4]) {
#pragma unroll
  for (int i = 0; i < 4; ++i) { const int idx = tid + 512 * i, kk = idx >> 5, c4 = idx & 31; w[i] = *(const f32x4*)(t.src + (size_t)(t.kc * 64 + kk) * t.ncols + t.hb * 128 + c4 * 4); }
}
__device__ __forceinline__ void tr_put(int tid, const f32x4 (&w)[4], float* tl) {
#pragma unroll
  for (int i = 0; i < 4; ++i) { const int idx = tid + 512 * i, kk = idx >> 5, c4 = idx & 31; float* q = tl + kk * 129 + c4 * 4; q[0] = w[i][0]; q[1] = w[i][1]; q[2] = w[i][2]; q[3] = w[i][3]; }
}
__device__ __forceinline__ void tr_out(const TrItem& t, int tid, const float* tl) {
#pragma unroll
  for (int i = 0; i < 2; ++i) { const int task = tid + 512 * i, o = task & 7, s = task >> 3;
    const int f = t.perm == 1 ? ((s & 0x43) | ((s & 0x10) << 1) | ((s & 0x20) >> 1) | ((s & 0x04) << 1) | ((s & 0x08) >> 1)) : t.perm == 2 ? ((s & 0x63) | ((s & 0x0C) << 1) | ((s & 0x10) >> 2)) : s;
    const float* q = tl + (8 * o) * 129 + f;
    u32x4 w = {cvtpk(q[0], q[129]), cvtpk(q[2 * 129], q[3 * 129]), cvtpk(q[4 * 129], q[5 * 129]), cvtpk(q[6 * 129], q[7 * 129])};
    *(u32x4*)(t.dst + (size_t)(t.hb * 128 + s) * LDH + t.kc * 64 + 8 * o) = w; }
}
__device__ __forceinline__ void p0_transpose2(const Params& p, int it0, int it1, char* shm) {
  const int tid = opaque_tid(); float* tl0 = (float*)shm; float* tl1 = tl0 + 64 * 129;
  const TrItem a = tr_item(p, it0); f32x4 wa[4], wb[4]; tr_load(a, tid, wa);
  if (it1 >= 0) { const TrItem b = tr_item(p, it1); tr_load(b, tid, wb); tr_put(tid, wa, tl0); tr_put(tid, wb, tl1); __syncthreads(); tr_out(a, tid, tl0); tr_out(b, tid, tl1); }
  else { tr_put(tid, wa, tl0); __syncthreads(); tr_out(a, tid, tl0); }
  __syncthreads();
}
__device__ __forceinline__ void p0_cache(const Params& p, int item) {
  bf16_t* dst = (bf16_t*)(p.ws + WS_CACHE); const int tid = opaque_tid();
#pragma unroll
  for (int i = 0; i < 8; ++i) { const size_t g = (size_t)item * 4096 + tid + 512 * i;
    const float* src; size_t gl;
    if (g < CAV_E / 8) { src = p.cak; gl = g; } else if (g < CBK_E / 8) { src = p.cav; gl = g - CAV_E / 8; } else if (g < CBV_E / 8) { src = p.cbk; gl = g - CBK_E / 8; } else { src = p.cbv; gl = g - CBV_E / 8; }
    const f32x8 x = *(const f32x8*)(src + gl * 8);
    u32x4 w = {cvtpk(x[0], x[1]), cvtpk(x[2], x[3]), cvtpk(x[4], x[5]), cvtpk(x[6], x[7])};
    *(u32x4*)(dst + g * 8) = w; }
}
__device__ __forceinline__ void p0_rope(const Params& p) {
  float* rc = (float*)(p.ws + WS_ROPE); float* rs = rc + 64 * 32; const int tid = opaque_tid();
#pragma unroll 1
  for (int q = 0; q < 4; ++q) { const int e = tid * 4 + q, pos = e >> 5, i = e & 31;
    double f = 1.0; for (int j = 0; j < i; ++j) f *= 0.7498942093324559;
    const double ang = (double)pos * f; const double kk = __builtin_rint(ang * 0.15915494309189535); const double r = ang - kk * 6.283185307179586, r2 = r * r;
    double s = r, c = 1.0, ts = r, tc = 1.0;
#pragma unroll 1
    for (int n = 1; n <= 15; ++n) { tc *= -r2 / (double)((2 * n - 1) * (2 * n)); c += tc; ts *= -r2 / (double)((2 * n) * (2 * n + 1)); s += ts; }
    rc[e] = (float)c; rs[e] = (float)s; }
}
__device__ __forceinline__ void phase0(const Params& p, char* shm) {
  const int G = (int)gridDim.x, c = (int)blockIdx.x;
  if (G >= 256) {
    if (c < P0_GEMV) p0_gemv(p, c, shm);
    constexpr int NPAIR = P0_WIN / 2, NA = 480;
    if (c < P0_GEMV) { for (int q = c; q < NA; q += P0_GEMV) p0_transpose2(p, P0_GEMV + 2 * q, P0_GEMV + 2 * q + 1, shm); }
    else { for (int q = NA + (c - P0_GEMV); q < NPAIR; q += G - P0_GEMV) p0_transpose2(p, P0_GEMV + 2 * q, P0_GEMV + 2 * q + 1, shm); }
    if (c == G - 1) p0_rope(p);
  } else {
    for (int it = c; it < P0_GEMV; it += G) p0_gemv(p, it, shm);
    for (int q = c; q < P0_WIN / 2; q += G) p0_transpose2(p, P0_GEMV + 2 * q, P0_GEMV + 2 * q + 1, shm);
    if (c == G - 1) p0_rope(p);
  }
}
__device__ __forceinline__ void phase0_late(const Params& p, char* shm, int first, int count) {
  const int r = (int)blockIdx.x - first; if (r < 0 || r >= count) return;
  for (int q = r; q < P0_WOUT / 2; q += count) p0_transpose2(p, P0_GEMV + P0_WIN + 2 * q, P0_GEMV + P0_WIN + 2 * q + 1, shm);
  for (int it = r; it < P0_CACHE; it += count) p0_cache(p, it);
}
__device__ __forceinline__ void phase1(const Params& p) {
  const int tid = opaque_tid(), wid = tid >> 6, lane = tid & 63; const float* mod = (const float*)(p.ws + WS_MOD); bf16_t* H = (bf16_t*)(p.ws + WS_H);
  const int nw = (int)gridDim.x * 8, per = (NTOK + nw - 1) / nw, w = blockIdx.x * 8 + wid;
  f32x4 A[4][2], B[4][2]; int vcur = -1;
  for (int row = w * per; row < min((w + 1) * per, NTOK); ++row) {
    const float* xr = row < NPR ? p.x_prompt + (size_t)row * DM : p.x_sample + (size_t)(row - NPR) * DM;
    const int v = row < NPR ? 8 : ((row - NPR) >> 11);
    f32x4 x[4][2]; float ss = 0.f;
#pragma unroll
    for (int i = 0; i < 4; ++i)
#pragma unroll
      for (int h = 0; h < 2; ++h) { x[i][h] = *(const f32x4*)(xr + (lane + 64 * i) * 8 + 4 * h); ss += x[i][h][0] * x[i][h][0] + x[i][h][1] * x[i][h][1] + x[i][h][2] * x[i][h][2] + x[i][h][3] * x[i][h][3]; }
    if (v != vcur) { vcur = v;
#pragma unroll
      for (int i = 0; i < 4; ++i)
#pragma unroll
        for (int h = 0; h < 2; ++h) { const int c = (lane + 64 * i) * 8 + 4 * h;
          A[i][h] = *(const f32x4*)(p.g_norm + c) * (*(const f32x4*)(mod + v * 6144 + 2048 + c) + 1.f); B[i][h] = *(const f32x4*)(mod + v * 6144 + c); } }
    ss = wave_sum(ss); const float rstd = rsqrtf(ss * (1.f / DM) + 1e-6f);
#pragma unroll
    for (int i = 0; i < 4; ++i) { const f32x4 h0 = (x[i][0] * rstd) * A[i][0] + B[i][0], h1 = (x[i][1] * rstd) * A[i][1] + B[i][1];
      u32x4 wv = {cvtpk(h0[0], h0[1]), cvtpk(h0[2], h0[3]), cvtpk(h1[0], h1[1]), cvtpk(h1[2], h1[3])};
      *(u32x4*)(H + (size_t)row * LDH + (lane + 64 * i) * 8) = wv; }
  }
}
__device__ __forceinline__ void phase5(const Params& p) {
  const int tid = opaque_tid(), wid = tid >> 6, lane = tid & 63; const bf16_t* Y = (const bf16_t*)(p.ws + WS_ZQ);
  f32x4 G[4][2];
#pragma unroll
  for (int i = 0; i < 4; ++i)
#pragma unroll
    for (int h = 0; h < 2; ++h) G[i][h] = *(const f32x4*)(p.g_final + (lane + 64 * i) * 8 + 4 * h);
  for (int row = blockIdx.x * 8 + wid; row < NTOK; row += gridDim.x * 8) {
    const bf16_t* yr = Y + (size_t)row * DM; float* orow = p.out + (size_t)row * DM;
    f32x4 x[4][2]; float ss = 0.f;
#pragma unroll
    for (int i = 0; i < 4; ++i) { const u32x4 w = *(const u32x4*)(yr + (lane + 64 * i) * 8);
      x[i][0][0] = __uint_as_float(w[0] << 16); x[i][0][1] = __uint_as_float(w[0] & 0xffff0000u); x[i][0][2] = __uint_as_float(w[1] << 16); x[i][0][3] = __uint_as_float(w[1] & 0xffff0000u);
      x[i][1][0] = __uint_as_float(w[2] << 16); x[i][1][1] = __uint_as_float(w[2] & 0xffff0000u); x[i][1][2] = __uint_as_float(w[3] << 16); x[i][1][3] = __uint_as_float(w[3] & 0xffff0000u);
#pragma unroll
      for (int h = 0; h < 2; ++h) ss += x[i][h][0] * x[i][h][0] + x[i][h][1] * x[i][h][1] + x[i][h][2] * x[i][h][2] + x[i][h][3] * x[i][h][3]; }
    ss = wave_sum(ss); const float rstd = rsqrtf(ss * (1.f / DM) + 1e-6f);
#pragma unroll
    for (int i = 0; i < 4; ++i)
#pragma unroll
      for (int h = 0; h < 2; ++h) *(f32x4*)(orow + (lane + 64 * i) * 8 + 4 * h) = x[i][h] * rstd * G[i][h];
  }
}
__device__ __forceinline__ void phase3(const Params& p, char* shm) {
  const bf16_t* ZQ = (const bf16_t*)(p.ws + WS_ZQ); const bf16_t* KV = (const bf16_t*)(p.ws + WS_KV); bf16_t* G = (bf16_t*)(p.ws + WS_H); const bf16_t* CB = (const bf16_t*)(p.ws + WS_CACHE);
  int tab_h = -1;
  unsigned* ctr = (unsigned*)(p.ws + WS_CTR); volatile LAS int* slot = (volatile LAS int*)((LAS unsigned char*)shm + (LDS_BYTES - 64));
  int it = blockIdx.x; bool dyn = false;
  for (;;) {
    __syncthreads();
    if (!dyn && it >= 1024) dyn = true;
    if (dyn) { if (threadIdx.x == 0) *slot = (int)__hip_atomic_fetch_add(ctr, 1u, __ATOMIC_RELAXED, __HIP_MEMORY_SCOPE_AGENT); __syncthreads(); it = 1024 + *slot; if (it >= 1536) break; }
    const bf16_t *Q, *K0, *V0, *K1, *V1, *Gt; bf16_t* O; int T0, NT, kr0 = 0, rw0 = 0;
    if (it < 512) { const int b = it >> 6, hq = (it >> 3) & 7, qb = it & 7, kvh = hq >> 2; const size_t rq = (size_t)NPR + b * 2048 + qb * 256;
      Q = ZQ + rq * DZ + ZQB + hq * 128; Gt = ZQ + rq * DZ + ZGB + hq * 128; O = G + rq * LDH + 1024 + hq * 128;
      K0 = KV + KBL_E + (size_t)(b * 2 + kvh) * 2048 * 128; V0 = KV + VBL_E + (size_t)(b * 2 + kvh) * 2048 * 128; T0 = 32;
      K1 = CB + CBK_E + (size_t)(b * 2 + kvh) * 512 * 128; V1 = CB + CBV_E + (size_t)(b * 2 + kvh) * 512 * 128; NT = 40;
    } else if (it < 1024) { const int i = it - 512, b = i >> 6, h = (i >> 3) & 7, rg = i & 7; const size_t rq = (size_t)NPR + b * 2048 + rg * 256;
      const int lo = min(max(4 * rg - 4, 0), 24), nb = (rg == 0 || rg == 7) ? 8 : 12;
      Q = ZQ + rq * DZ + ZQA + h * 128; Gt = ZQ + rq * DZ + ZGA + h * 128; O = G + rq * LDH + h * 128;
      K0 = CB + CAK_E + (size_t)(b * 8 + h) * 512 * 128; V0 = CB + CAV_E + (size_t)(b * 8 + h) * 512 * 128; T0 = 8;
      K1 = KV + KAL_E + ((size_t)(b * 8 + h) * 2048 + lo * 64) * 128; V1 = KV + VAL_E + ((size_t)(b * 8 + h) * 2048 + lo * 64) * 128; NT = 8 + nb; kr0 = lo; rw0 = 4 * rg;
      if (h != tab_h) { tab_h = h; const int tb = opaque_tid(); float* rp = (float*)(shm + att::OFF_RPB); float* ti = (float*)(shm + att::OFF_BIAS); float* te = (float*)(shm + att::OFF_TEDGE);
        if (tb < 465) rp[tb] = p.rpb[h * 465 + tb] * (1.f / att::SCALE);
        __syncthreads();
        for (int i = tb; i < 15 * 128; i += 512) { const int ro = i >> 7, dd = (i & 127) - 48; ti[i] = (dd >= 7 && dd <= 22) ? rp[ro * 31 + dd] : -1e30f; }
        for (int i = tb; i < 15 * 960; i += 512) { const int ro = i / 960, rem = i - ro * 960, eq = rem >> 6, kc = rem & 63, qcol = eq < 8 ? eq : eq + 49;
          const int cst = min(max(qcol - 8, 0), 48), dd = kc - qcol + 15; te[i] = ((unsigned)(kc - cst) < 16u) ? rp[ro * 31 + dd] : -1e30f; } }
    } else if (it < 1280) { const int i = it - 1024, b = i >> 3, h = i & 7; const size_t r0 = (size_t)b * 256;
      Q = ZQ + r0 * DZ + ZQA + h * 128; Gt = ZQ + r0 * DZ + ZGA + h * 128; O = G + r0 * LDH + h * 128;
      K0 = KV + KAC_E + (size_t)(b * 8 + h) * 256 * 128; V0 = KV + VAC_E + (size_t)(b * 8 + h) * 256 * 128; T0 = 4; K1 = K0; V1 = V0; NT = 4;
    } else { const int i = it - 1280, b = i >> 3, hq = i & 7, kvh = hq >> 2; const size_t r0 = (size_t)b * 256;
      Q = ZQ + r0 * DZ + ZQB + hq * 128; Gt = ZQ + r0 * DZ + ZGB + hq * 128; O = G + r0 * LDH + 1024 + hq * 128;
      K0 = KV + KBC_E + (size_t)(b * 2 + kvh) * 256 * 128; V0 = KV + VBC_E + (size_t)(b * 2 + kvh) * 256 * 128; T0 = 4; K1 = K0; V1 = V0; NT = 4;
    }
    if (it >= 512 && it < 1024) att::attn_item<1>(Q, K0, V0, T0, K1, V1, NT, Gt, O, kr0, rw0, shm);
    else { att::attn_item<0>(Q, K0, V0, T0, K1, V1, NT, Gt, O, 0, 0, shm); tab_h = -1; }
    if (!dyn) it += gridDim.x;
  }
}

__global__ void __launch_bounds__(512, 2) hymba_megakernel(Params p) {
  extern __shared__ __attribute__((aligned(16))) unsigned char shm[];
  cg::grid_group grid = cg::this_grid();
#ifndef RP
#define RP 0
#endif
  volatile LAS unsigned* xst = (volatile LAS unsigned*)((LAS unsigned char*)shm + (LDS_BYTES - 16));
  unsigned* xbar = (unsigned*)(p.ws + WS_BAR);
  if (threadIdx.x < 4) xst[threadIdx.x] = 0u;
  if (blockIdx.x == 0) for (int i = threadIdx.x; i < XCD_BAR_WORDS + 64; i += 512) __hip_atomic_store(xbar + i, 0u, __ATOMIC_RELAXED, __HIP_MEMORY_SCOPE_AGENT);
  for (int rep = 0; rep < ((RP & 1) ? 2 : 1); ++rep) { phase0(p, (char*)shm); __syncthreads(); }
  grid.sync();
  const XcdBarrier xb = xcd_barrier_post(xbar, xst);
#define GSYNC() xcd_barrier(xb)
  for (int rep = 0; rep < ((RP & 2) ? 2 : 1); ++rep) phase1(p);
  GSYNC();
  for (int rep = 0; rep < ((RP & 4) ? 2 : 1); ++rep) { pg8::Gemm g; g.A = (const bf16_t*)(p.ws + WS_H); g.Bt = (const bf16_t*)(p.ws + WS_WTIN); g.M = NTOK; g.N = DIN; g.K = DM; g.ld = LDH;
    pg8::StaticOrder S; S.init(g.M, g.N, (int)gridDim.x, (int)blockIdx.x); S.spread = 1;
    Epi1 E; E.ZQ = (bf16_t*)(p.ws + WS_ZQ); E.KV = (bf16_t*)(p.ws + WS_KV); E.out = p.out; E.gq = p.g_q; E.gk = p.g_k; E.ropeC = (const float*)(p.ws + WS_ROPE); E.ropeS = E.ropeC + 64 * 32;
    E.part = (LAS float*)((LAS unsigned char*)shm + pg8::STAGE_BYTES);
    pg8::gemm_phase<Epi1, pg8::StaticOrder>((LAS unsigned char*)shm, g, S, E); }
  { const int G = (int)gridDim.x, rem = (NTOK / 256) * (DIN / 256) % G;
    if (rem) phase0_late(p, (char*)shm, rem, G - rem); else phase0_late(p, (char*)shm, 0, G); }
  GSYNC();
  for (int rep = 0; rep < ((RP & 8) ? 2 : 1); ++rep) phase3(p, (char*)shm);
  GSYNC();
  for (int rep = 0; rep < ((RP & 16) ? 2 : 1); ++rep) { pg8::Gemm g; g.A = (const bf16_t*)(p.ws + WS_H); g.Bt = (const bf16_t*)(p.ws + WS_WTOUT); g.M = NTOK; g.N = DM; g.K = DM; g.ld = LDH;
    pg8::StaticOrder S; S.init(g.M, g.N, (int)gridDim.x, (int)blockIdx.x);
    Epi2 E; E.xp = p.x_prompt; E.xs = p.x_sample; E.mod = (const float*)(p.ws + WS_MOD); E.Y = (bf16_t*)(p.ws + WS_ZQ);
    pg8::gemm_phase<Epi2, pg8::StaticOrder>((LAS unsigned char*)shm, g, S, E); }
  GSYNC();
  phase5(p);
}

extern "C" void kernel_launch(void* const* d_in, const int* in_sizes, int n_in, void* d_out, int out_size, void* d_ws, size_t ws_size, hipStream_t stream) {
  static int grid_blocks = 0;
  if (!grid_blocks) {
    if (ws_size < WS_END) { fprintf(stderr, "kernel_launch: workspace too small: %zu < %zu\n", ws_size, (size_t)WS_END); return; }
    if (hipFuncSetAttribute((const void*)hymba_megakernel, hipFuncAttributeMaxDynamicSharedMemorySize, LDS_BYTES) != hipSuccess) { fprintf(stderr, "kernel_launch: hipFuncSetAttribute failed\n"); return; }
    int dev = 0, cus = 0, per_cu = 0;
    (void)hipGetDevice(&dev); (void)hipDeviceGetAttribute(&cus, hipDeviceAttributeMultiprocessorCount, dev);
    (void)hipOccupancyMaxActiveBlocksPerMultiprocessor(&per_cu, hymba_megakernel, 512, LDS_BYTES);
    if (per_cu < 1 || cus < 1) { fprintf(stderr, "kernel_launch: occupancy query says %d blocks/CU on %d CUs\n", per_cu, cus); return; }
    grid_blocks = cus;
  }
  Params p{};
  p.x_prompt = (const float*)d_in[0]; p.x_sample = (const float*)d_in[1]; p.cak = (const float*)d_in[2]; p.cav = (const float*)d_in[3]; p.cbk = (const float*)d_in[4]; p.cbv = (const float*)d_in[5];
  p.c = (const float*)d_in[6]; p.c_ctx = (const float*)d_in[7]; p.w_ada = (const float*)d_in[8]; p.b_ada = (const float*)d_in[9]; p.g_norm = (const float*)d_in[10]; p.w_in = (const float*)d_in[11];
  p.rpb = (const float*)d_in[12]; p.g_q = (const float*)d_in[13]; p.g_k = (const float*)d_in[14]; p.w_out = (const float*)d_in[15]; p.g_final = (const float*)d_in[16];
  p.out = (float*)d_out; p.ws = (unsigned char*)d_ws;
  void* args[] = {&p};
  hipError_t e = hipLaunchCooperativeKernel((const void*)hymba_megakernel, dim3(grid_blocks), dim3(512), args, LDS_BYTES, stream);
  if (e != hipSuccess) fprintf(stderr, "cooperative launch failed: %s (grid %d)\n", hipGetErrorString(e), grid_blocks);
}
```
